# Optimizing an MI355X kernel written in HIP

```python
import jax, jax.numpy as jnp
from jax import lax
import numpy as np

D_MODEL = 2048
BATCH = 4
SEQ = 4096
DEPTH = 1

GRID_W = 64
CTX_LEN = 256
HEAD_DIM = 128
N_Q_HEADS = 16
N_KV_HEADS = 4
GQA_GROUP = N_Q_HEADS // N_KV_HEADS
ATTN_W = N_Q_HEADS * HEAD_DIM
KV_W = N_KV_HEADS * HEAD_DIM
LRU_W = D_MODEL
LRU_BLOCKS = 16
LRU_BLOCK_DIM = LRU_W // LRU_BLOCKS
LRU_C = 8.0
CONV_W = 4
CONV_LEFT = 2
D_FF = 5632
Q_BLOCK = 128
ROPE_THETA = 10000.0
EPS = 1e-6
N_MOD = 9
FFN_RES = 0.5
OFF_Q = 0
OFF_K = OFF_Q + ATTN_W
OFF_V = OFF_K + KV_W
OFF_LX = OFF_V + KV_W
OFF_LG = OFF_LX + LRU_W
OFF_GA = OFF_LG + LRU_W
OFF_GL = OFF_GA + D_MODEL
IN_W = OFF_GL + D_MODEL

kernel_name = 'hybrid_gqa_rglru_macaron_dit_layer'


def rms_norm(t, g):
    tf = t.astype(jnp.float32)
    y = tf * lax.rsqrt(jnp.mean(tf * tf, axis=-1, keepdims=True) + EPS)
    return (y * g.astype(jnp.float32)).astype(t.dtype)


def modulate(h, shift, scale):
    return h * (1.0 + scale) + shift


def swiglu(h, wg, wu, wd):
    return (jax.nn.silu(h @ wg) * (h @ wu)) @ wd


def axial_rope_tables(n_tok):
    rows = n_tok // GRID_W
    row = jnp.repeat(jnp.arange(rows, dtype=jnp.float32), GRID_W)
    col = jnp.tile(jnp.arange(GRID_W, dtype=jnp.float32), rows)
    axis_dims = HEAD_DIM // 2
    freqs = ROPE_THETA ** (-jnp.arange(0, axis_dims, 2, dtype=jnp.float32) / axis_dims)
    ang = jnp.concatenate([row[:, None] * freqs, col[:, None] * freqs], axis=-1)
    return jnp.cos(ang), jnp.sin(ang)


def apply_rope(t, cos, sin):
    tf = t.astype(jnp.float32).reshape(t.shape[:-1] + (HEAD_DIM // 2, 2))
    t1, t2 = tf[..., 0], tf[..., 1]
    out = jnp.stack([t1 * cos - t2 * sin, t1 * sin + t2 * cos], axis=-1)
    return out.reshape(t.shape).astype(t.dtype)


def to_heads(t, n_heads):
    b, n, _ = t.shape
    return t.reshape(b, n, n_heads, HEAD_DIM).transpose(0, 2, 1, 3)


def group_queries(q):
    b, _, n, _ = q.shape
    return q.reshape(b, N_KV_HEADS, GQA_GROUP, n, HEAD_DIM)


def latent_attention(q, k_lat, v_lat, k_ctx, v_ctx):
    b, _, _, n, _ = q.shape
    k_all = jnp.concatenate([k_ctx, k_lat], axis=2)
    v_all = jnp.concatenate([v_ctx, v_lat], axis=2)
    n_blk = n // Q_BLOCK
    qb = jnp.moveaxis(q.reshape(b, N_KV_HEADS, GQA_GROUP, n_blk, Q_BLOCK, HEAD_DIM), 3, 0)
    scale = HEAD_DIM ** -0.5

    def one_block(q_blk):
        s = jnp.einsum('bkgqd,bksd->bkgqs', q_blk, k_all, preferred_element_type=jnp.float32) * scale
        p = jax.nn.softmax(s, axis=-1)
        return jnp.einsum('bkgqs,bksd->bkgqd', p.astype(v_all.dtype), v_all)

    ob = lax.map(one_block, qb)
    return ob.transpose(1, 0, 4, 2, 3, 5).reshape(b, n, ATTN_W)


def context_attention(q, k, v):
    b, _, _, n, _ = q.shape
    s = jnp.einsum('bkgqd,bksd->bkgqs', q, k, preferred_element_type=jnp.float32) * (HEAD_DIM ** -0.5)
    p = jax.nn.softmax(s, axis=-1)
    o = jnp.einsum('bkgqs,bksd->bkgqd', p.astype(v.dtype), v)
    return o.transpose(0, 3, 1, 2, 4).reshape(b, n, ATTN_W)


def centred_dwconv(t, w, b):
    n = t.shape[1]
    tp = jnp.pad(t, ((0, 0), (CONV_LEFT, CONV_W - 1 - CONV_LEFT), (0, 0)))
    out = b
    for k in range(CONV_W):
        out = out + tp[:, k:k + n] * w[k]
    return out


def block_diag(t, w, b):
    tb = t.reshape(t.shape[:-1] + (LRU_BLOCKS, LRU_BLOCK_DIM))
    return jnp.einsum('btnd,nde->btne', tb, w).reshape(t.shape) + b


def rglru_coeffs(xc, w_a, b_a, w_x, b_x, lam):
    xf = xc.astype(jnp.float32)
    r = jax.nn.sigmoid(block_diag(xf, w_a, b_a).astype(jnp.float32))
    i = jax.nn.sigmoid(block_diag(xf, w_x, b_x).astype(jnp.float32))
    log_a = -LRU_C * r * jax.nn.softplus(-lam.astype(jnp.float32))
    a = jnp.exp(log_a)
    u = jnp.sqrt(-jnp.expm1(2.0 * log_a)) * (i * xf)
    return a, u


def linear_scan(a, u, h0, reverse):
    def combine(e1, e2):
        a1, b1 = e1
        a2, b2 = e2
        return a1 * a2, a2 * b1 + b2
    a_cum, b_cum = lax.associative_scan(combine, (a, u), axis=1, reverse=reverse)
    return a_cum * h0[:, None, :] + b_cum


def rglru_bidir(xc, h0_f, h0_b, wa, ba, wx, bx, lam):
    a_f, u_f = rglru_coeffs(xc, wa[0], ba[0], wx[0], bx[0], lam[0])
    a_b, u_b = rglru_coeffs(xc, wa[1], ba[1], wx[1], bx[1], lam[1])
    return linear_scan(a_f, u_f, h0_f, False), linear_scan(a_b, u_b, h0_b, True)


def gated_lru_out(h_f, h_b, gate, dtype):
    return ((h_f + h_b) * jax.nn.gelu(gate.astype(jnp.float32))).astype(dtype)


def merge_branches(attn, lru, ga, gl, w_out):
    return (jax.nn.sigmoid(ga) * attn + jax.nn.sigmoid(gl) * lru) @ w_out


def hybrid_layer(x, ctx, c, c_ctx, w_mod, b_mod, norm_g, ffn_wg, ffn_wu, ffn_wd, w_in, w_out,
                 q_norm_g, k_norm_g, conv_w, conv_b, lru_wa, lru_ba, lru_wx, lru_bx, lru_lambda,
                 cos, sin, update_ctx):
    b = x.shape[0]
    mod_x = (jax.nn.silu(c) @ w_mod + b_mod).reshape(b, N_MOD, 1, D_MODEL)
    mod_c = (jax.nn.silu(c_ctx) @ w_mod + b_mod).reshape(N_MOD, D_MODEL)
    sh1, sc1, g1, sh2, sc2, g2, sh3, sc3, g3 = [mod_x[:, i] for i in range(N_MOD)]
    csh1, csc1, cg1, csh2, csc2, cg2, csh3, csc3, cg3 = [mod_c[i] for i in range(N_MOD)]

    x = x + FFN_RES * g1 * swiglu(modulate(rms_norm(x, norm_g[0]), sh1, sc1), ffn_wg[0], ffn_wu[0], ffn_wd[0])
    ctx = ctx + FFN_RES * cg1 * swiglu(modulate(rms_norm(ctx, norm_g[0]), csh1, csc1), ffn_wg[0], ffn_wu[0], ffn_wd[0])

    hx = modulate(rms_norm(x, norm_g[1]), sh2, sc2)
    hc = modulate(rms_norm(ctx, norm_g[1]), csh2, csc2)

    pc = hc @ w_in[:, OFF_K:OFF_LG]
    k_c = rms_norm(to_heads(pc[..., :KV_W], N_KV_HEADS), k_norm_g)
    v_c = to_heads(pc[..., KV_W:2 * KV_W], N_KV_HEADS)
    xc_c = centred_dwconv(pc[..., 2 * KV_W:], conv_w, conv_b)
    zeros = jnp.zeros((b, LRU_W), jnp.float32)
    hf_c, hb_c = rglru_bidir(xc_c, zeros, zeros, lru_wa, lru_ba, lru_wx, lru_bx, lru_lambda)

    p = hx @ w_in
    q = apply_rope(rms_norm(to_heads(p[..., OFF_Q:OFF_K], N_Q_HEADS), q_norm_g), cos, sin)
    k = apply_rope(rms_norm(to_heads(p[..., OFF_K:OFF_V], N_KV_HEADS), k_norm_g), cos, sin)
    v = to_heads(p[..., OFF_V:OFF_LX], N_KV_HEADS)
    attn = latent_attention(group_queries(q), k, v, k_c, v_c)
    xc = centred_dwconv(p[..., OFF_LX:OFF_LG], conv_w, conv_b)
    hf, hb = rglru_bidir(xc, hf_c[:, -1], hb_c[:, 0], lru_wa, lru_ba, lru_wx, lru_bx, lru_lambda)
    lru = gated_lru_out(hf, hb, p[..., OFF_LG:OFF_GA], x.dtype)
    x = x + g2 * merge_branches(attn, lru, p[..., OFF_GA:OFF_GL], p[..., OFF_GL:], w_out)

    if update_ctx:
        pq_c = hc @ w_in[:, OFF_Q:OFF_K]
        pg_c = hc @ w_in[:, OFF_LG:]
        q_c = rms_norm(to_heads(pq_c, N_Q_HEADS), q_norm_g)
        attn_c = context_attention(group_queries(q_c), k_c, v_c)
        lru_c = gated_lru_out(hf_c, hb_c, pg_c[..., :LRU_W], ctx.dtype)
        ctx = ctx + cg2 * merge_branches(attn_c, lru_c, pg_c[..., LRU_W:LRU_W + D_MODEL],
                                         pg_c[..., LRU_W + D_MODEL:], w_out)

    x = x + FFN_RES * g3 * swiglu(modulate(rms_norm(x, norm_g[2]), sh3, sc3), ffn_wg[1], ffn_wu[1], ffn_wd[1])
    if update_ctx:
        ctx = ctx + FFN_RES * cg3 * swiglu(modulate(rms_norm(ctx, norm_g[2]), csh3, csc3), ffn_wg[1], ffn_wu[1], ffn_wd[1])
    return x, ctx


def setup_inputs(seed: int = 0) -> dict:
    key = jax.random.key(seed)
    ks = jax.random.split(key, 24)
    f32 = jnp.float32

    def nrm(k, shape, scale):
        return jax.random.normal(k, shape, f32) * scale

    u = jax.random.uniform(ks[20], (DEPTH, 2, LRU_W), f32, 0.9, 0.999)
    base = u ** (1.0 / LRU_C)
    return {
        'x': nrm(ks[0], (BATCH, SEQ, D_MODEL), 1.0),
        'c': nrm(ks[1], (BATCH, D_MODEL), 1.0),
        'ctx': nrm(ks[2], (BATCH, CTX_LEN, D_MODEL), 1.0),
        'c_ctx': nrm(ks[3], (D_MODEL,), 1.0),
        'w_mod': nrm(ks[4], (DEPTH, D_MODEL, N_MOD * D_MODEL), 0.5 * D_MODEL ** -0.5),
        'b_mod': nrm(ks[5], (DEPTH, N_MOD * D_MODEL), 0.01),
        'norm_g': 1.0 + nrm(ks[6], (DEPTH, 3, D_MODEL), 0.02),
        'ffn_wg': nrm(ks[7], (DEPTH, 2, D_MODEL, D_FF), D_MODEL ** -0.5),
        'ffn_wu': nrm(ks[8], (DEPTH, 2, D_MODEL, D_FF), D_MODEL ** -0.5),
        'ffn_wd': nrm(ks[9], (DEPTH, 2, D_FF, D_MODEL), D_FF ** -0.5),
        'w_in': nrm(ks[10], (DEPTH, D_MODEL, IN_W), D_MODEL ** -0.5),
        'w_out': nrm(ks[11], (DEPTH, D_MODEL, D_MODEL), D_MODEL ** -0.5),
        'q_norm_g': 1.0 + nrm(ks[12], (DEPTH, HEAD_DIM), 0.02),
        'k_norm_g': 1.0 + nrm(ks[13], (DEPTH, HEAD_DIM), 0.02),
        'conv_w': nrm(ks[14], (DEPTH, CONV_W, LRU_W), CONV_W ** -0.5),
        'conv_b': nrm(ks[15], (DEPTH, LRU_W), 0.01),
        'lru_wa': nrm(ks[16], (DEPTH, 2, LRU_BLOCKS, LRU_BLOCK_DIM, LRU_BLOCK_DIM), LRU_BLOCK_DIM ** -0.5),
        'lru_ba': nrm(ks[17], (DEPTH, 2, LRU_W), 0.01),
        'lru_wx': nrm(ks[18], (DEPTH, 2, LRU_BLOCKS, LRU_BLOCK_DIM, LRU_BLOCK_DIM), LRU_BLOCK_DIM ** -0.5),
        'lru_bx': nrm(ks[19], (DEPTH, 2, LRU_W), 0.01),
        'lru_lambda': jnp.log(base) - jnp.log1p(-base),
        'final_norm_g': 1.0 + nrm(ks[21], (D_MODEL,), 0.02),
    }


def reference(x, c, ctx, c_ctx, w_mod, b_mod, norm_g, ffn_wg, ffn_wu, ffn_wd, w_in, w_out,
              q_norm_g, k_norm_g, conv_w, conv_b, lru_wa, lru_ba, lru_wx, lru_bx, lru_lambda,
              final_norm_g):
    cos, sin = axial_rope_tables(x.shape[1])
    for l in range(DEPTH):
        x, ctx = hybrid_layer(x, ctx, c, c_ctx, w_mod[l], b_mod[l], norm_g[l], ffn_wg[l], ffn_wu[l], ffn_wd[l],
                              w_in[l], w_out[l], q_norm_g[l], k_norm_g[l], conv_w[l], conv_b[l],
                              lru_wa[l], lru_ba[l], lru_wx[l], lru_bx[l], lru_lambda[l],
                              cos, sin, l < DEPTH - 1)
    return rms_norm(x, final_norm_g)
```

```cpp
#include <hip/hip_runtime.h>
#include <hip/hip_cooperative_groups.h>
#include <cstdio>
#include <cstdint>
namespace cg = cooperative_groups;

#define LAS __attribute__((address_space(3)))
typedef unsigned short bf16_t;
typedef short bf16x8 __attribute__((ext_vector_type(8)));
typedef short s16x4 __attribute__((ext_vector_type(4)));
typedef float f32x4 __attribute__((ext_vector_type(4)));
typedef float f32x2 __attribute__((ext_vector_type(2)));
typedef float f32x16 __attribute__((ext_vector_type(16)));
typedef unsigned u32x4 __attribute__((ext_vector_type(4)));
typedef unsigned u32x2 __attribute__((ext_vector_type(2)));

constexpr int NWAVES = 8, NTHR = 512;
constexpr int LDS_BYTES = 147456;
constexpr int DM = 2048, MLAT = 16384, MCTX = 1024, MALL = 17408, SEQ = 4096, CTXL = 256;
constexpr int DFF = 5632, NGU = 11264, INW = 11264, NMODC = 18432;
constexpr int KVW = 512, SKV = 4352;
constexpr float EPS = 1e-6f;
constexpr size_t MiB = 1u << 20;
constexpr size_t WS_MOD = 0;
constexpr size_t WS_MODP = 1 * MiB;
constexpr size_t WS_CA = 13 * MiB, WS_CB = 18 * MiB, WS_SS = 23 * MiB;
constexpr size_t WS_XC1 = 28 * MiB;
constexpr size_t WS_WOUT = 36 * MiB;
constexpr size_t WS_WLRU = 44 * MiB;
constexpr size_t WS_W1X = 46 * MiB;
constexpr size_t WS_WGU = WS_W1X, WS_WD = WS_W1X + 44 * MiB, WS_WIN = WS_W1X + 66 * MiB;
constexpr size_t WS_LAB = WS_W1X, WS_UB = WS_W1X + 68 * MiB;
constexpr size_t WS_H = 182 * MiB;
constexpr size_t WS_ARENA = 250 * MiB;
constexpr size_t WS_ACT = WS_ARENA;
constexpr size_t WS_Q = WS_ARENA, WS_GA = WS_ARENA + 64 * MiB, WS_K = WS_ARENA + 128 * MiB, WS_V = WS_ARENA + 145 * MiB,
                 WS_LX = WS_ARENA + 162 * MiB, WS_LG = WS_ARENA + 230 * MiB, WS_GL = WS_ARENA + 294 * MiB;
constexpr size_t WS_LAF = WS_GA, WS_UF = WS_LX;
constexpr size_t WS_END = WS_ARENA + 358 * MiB;

__device__ __forceinline__ unsigned cvt_pk_bf16(float lo, float hi) { unsigned r; asm volatile("v_cvt_pk_bf16_f32 %0, %1, %2" : "=v"(r) : "v"(lo), "v"(hi)); return r; }
__device__ __forceinline__ float bf_lo(unsigned w) { return __uint_as_float(w << 16); }
__device__ __forceinline__ float bf_hi(unsigned w) { return __uint_as_float(w & 0xffff0000u); }
__device__ __forceinline__ float bf2f(bf16_t h) { return __uint_as_float(((unsigned)h) << 16); }
__device__ __forceinline__ bf16_t f2bf(float f) { unsigned u = __float_as_uint(f); return (bf16_t)((u + 0x7fffu + ((u >> 16) & 1u)) >> 16); }
__device__ __forceinline__ float sigmoidf_(float v) { return __builtin_amdgcn_rcpf(1.0f + __builtin_amdgcn_exp2f(-1.4426950408889634f * v)); }
__device__ __forceinline__ float siluf_(float v) { return v * sigmoidf_(v); }
__device__ __forceinline__ float gelu_tanh(float v) { const float z = 0.7978845608028654f * (v + 0.044715f * v * v * v); return v * sigmoidf_(2.0f * z); }
__device__ __forceinline__ float expf_(float v) { return __builtin_amdgcn_exp2f(1.4426950408889634f * v); }
__device__ __forceinline__ float wave_sum(float v) {
#pragma unroll
    for (int o = 1; o < 64; o <<= 1) v += __shfl_xor(v, o);
    return v;
}
__device__ __forceinline__ void unpack8(const u32x4 w, float (&x)[8]) {
    x[0] = bf_lo(w.x); x[1] = bf_hi(w.x); x[2] = bf_lo(w.y); x[3] = bf_hi(w.y); x[4] = bf_lo(w.z); x[5] = bf_hi(w.z); x[6] = bf_lo(w.w); x[7] = bf_hi(w.w);
}
__device__ __forceinline__ u32x4 pack8(const float (&x)[8]) {
    u32x4 w; w.x = cvt_pk_bf16(x[0], x[1]); w.y = cvt_pk_bf16(x[2], x[3]); w.z = cvt_pk_bf16(x[4], x[5]); w.w = cvt_pk_bf16(x[6], x[7]); return w;
}

namespace pg8 {
constexpr int BM = 256, BK = 64, HALF = 128, HTB = HALF * BK * 2, STAGE_BYTES = 8 * HTB, NXCD = 8, WGM = 8;
__device__ __forceinline__ int lds_byte(int r, int c) { const int st = (r >> 4) * 2 + (c >> 5), rr = r & 15, cc = c & 31, ob = rr * 64 + cc * 2; return st * 1024 + (ob ^ (((ob >> 9) & 1) << 5)); }
__device__ __forceinline__ void stage_rc(int b, int& R, int& C) { const int st = b / 1024, sb = b % 1024, swz = sb ^ (((sb >> 9) & 1) << 5); R = (st >> 1) * 16 + swz / 64; C = (st & 1) * 32 + (swz % 64) / 2; }
__device__ __forceinline__ int perm32(int rho) { const int n = rho >> 4, i = rho & 15; return 8 * (i >> 2) + 4 * n + (i & 3); }

struct Unit { int pm, pn, ka; };
struct Gemm { const bf16_t* A; const bf16_t* Bt; int lda, ldb, K; };

struct StaticOrder {
    int nM, nN, nwg, G, c;
    __device__ void init(int M, int N, int G_, int c_) { nM = M / BM; nN = N / BM; nwg = nM * nN; G = G_; c = c_; }
    __device__ bool next(int i, Unit& u) const {
        const long L = (long)i * G + c; if (L >= nwg) return false;
        int wgid = (int)L; { const int q = nwg / NXCD, r = nwg % NXCD, xcd = wgid % NXCD, off = wgid / NXCD; wgid = (xcd < r ? xcd * (q + 1) : r * (q + 1) + (xcd - r) * q) + off; }
        const int nig = WGM * nN, gid = wgid / nig, fm = gid * WGM, gsz = (nM - fm) < WGM ? (nM - fm) : WGM;
        u.pm = fm + ((wgid % nig) % gsz); u.pn = (wgid % nig) / gsz; u.ka = 0; return true;
    }
};
struct LruOrder {
    int G, c;
    __device__ bool next(int i, Unit& u) const {
        const int L = i * G + c; if (L >= 68 * 32) return false;
        u.pn = L & 31; u.pm = L >> 5; u.ka = (u.pn >> 1) * 128; return true;
    }
};

template <class Epi, class Sched>
__device__ __forceinline__ void gemm_phase(LAS unsigned char* lds, const Gemm g, const Sched& S, const Epi& E) {
    int tid = threadIdx.x; asm volatile("" : "+v"(tid));
    const int wid = __builtin_amdgcn_readfirstlane(tid >> 6), lane = tid & 63, wr = wid >> 2, wc = wid & 3, fr = lane & 15, fq = lane >> 4;
    const int nt = g.K / BK;
    unsigned voffA[2], voffB[2];
#pragma unroll
    for (int i = 0; i < 2; ++i) { int R, C; stage_rc(tid * 16 + i * 8192, R, C); const int Rb = Epi::PERM ? ((R & ~31) + perm32(R & 31)) : R;
        voffA[i] = (unsigned)(R * g.lda + C) * 2u; voffB[i] = (unsigned)(Rb * g.ldb + C) * 2u; }
    const size_t kstep = (size_t)(BK * 2);
    const size_t hA = (size_t)HALF * g.lda * 2, hB = (size_t)HALF * g.ldb * 2;
    const unsigned ldsw = (unsigned)wid * 1024u;
    const int aoff = lds_byte(wr * 64 + fr, fq * 8), boff = lds_byte(wc * 32 + fr, fq * 8);
#define PG8_SA(b, h) (((b) * 2 + (h)) * HTB)
#define PG8_SB(b, h) ((4 + (b) * 2 + (h)) * HTB)
#define PG8_STAGE(bufoff, gbase, voff) do { _Pragma("unroll") for (int _i = 0; _i < 2; ++_i) \
        __builtin_amdgcn_global_load_lds((const unsigned*)((const char*)(gbase) + (voff)[_i]), (LAS unsigned*)(lds + (bufoff) + ldsw + _i * 8192), 16, 0, 0); } while (0)
#define PG8_LDA(dst, b, h) do { _Pragma("unroll") for (int m = 0; m < 4; ++m) _Pragma("unroll") for (int k = 0; k < 2; ++k) dst[m][k] = *(const LAS bf16x8*)(lds + PG8_SA(b, h) + aoff + m * 2048 + k * 1024); } while (0)
#define PG8_LDB(dst, b, h) do { _Pragma("unroll") for (int n = 0; n < 2; ++n) _Pragma("unroll") for (int k = 0; k < 2; ++k) dst[n][k] = *(const LAS bf16x8*)(lds + PG8_SB(b, h) + boff + n * 2048 + k * 1024); } while (0)
#define PG8_MMA(ai, bj, At, Bt) do { __builtin_amdgcn_s_setprio(1); _Pragma("unroll") for (int m = 0; m < 4; ++m) _Pragma("unroll") for (int n = 0; n < 2; ++n) _Pragma("unroll") for (int k = 0; k < 2; ++k) \
        acc[ai][bj][m][n] = __builtin_amdgcn_mfma_f32_16x16x32_bf16(Bt[n][k], At[m][k], acc[ai][bj][m][n], 0, 0, 0); __builtin_amdgcn_s_setprio(0); } while (0)
#define PG8_WAIT_V(n) asm volatile("s_waitcnt vmcnt(" #n ")" ::: "memory")
#define PG8_WAIT_L(n) asm volatile("s_waitcnt lgkmcnt(" #n ")" ::: "memory")
#define PG8_BAR __builtin_amdgcn_s_barrier()
#define PG8_SCHED __builtin_amdgcn_sched_barrier(0)
    Unit cur, nxt; int ui = 0;
    if (!S.next(0, cur)) return;
    f32x4 acc[2][2][4][2];
#pragma unroll
    for (int a = 0; a < 2; ++a)
#pragma unroll
        for (int b = 0; b < 2; ++b)
#pragma unroll
            for (int m = 0; m < 4; ++m)
#pragma unroll
                for (int n = 0; n < 2; ++n) acc[a][b][m][n] = (f32x4){0.f, 0.f, 0.f, 0.f};
    bf16x8 At[4][2], B0[2][2], B1[2][2];
    const char* cA = (const char*)g.A + (size_t)cur.pm * 2 * hA + (size_t)cur.ka * 2; const char* cB = (const char*)g.Bt + (size_t)cur.pn * 2 * hB;
    PG8_STAGE(PG8_SB(0, 0), cB, voffB); PG8_STAGE(PG8_SB(0, 1), cB + hB, voffB); PG8_STAGE(PG8_SA(0, 0), cA, voffA); PG8_STAGE(PG8_SA(0, 1), cA + hA, voffA);
    if (wr == 1) PG8_BAR;
    PG8_WAIT_V(2); PG8_BAR;
    PG8_STAGE(PG8_SB(1, 0), cB + kstep, voffB); PG8_STAGE(PG8_SA(1, 0), cA + kstep, voffA); PG8_STAGE(PG8_SB(1, 1), cB + hB + kstep, voffB);
    PG8_WAIT_V(6); PG8_BAR;
    for (;;) {
        const bool has_next = S.next(ui + 1, nxt);
        const char* nA = has_next ? (const char*)g.A + (size_t)nxt.pm * 2 * hA + (size_t)nxt.ka * 2 : cA; const char* nB = has_next ? (const char*)g.Bt + (size_t)nxt.pn * 2 * hB : cB;
        for (int t = 0; t < nt; t += 2) {
            const bool last = (t == nt - 2);
            const char* a1 = cA + (size_t)(t + 1) * kstep;
            const char* a2 = last ? nA : cA + (size_t)(t + 2) * kstep; const char* b2 = last ? nB : cB + (size_t)(t + 2) * kstep;
            const char* a3 = a2 + kstep; const char* b3 = b2 + kstep;
            PG8_LDB(B0, 0, 0); PG8_LDB(B1, 0, 1); PG8_SCHED; PG8_LDA(At, 0, 0); PG8_STAGE(PG8_SA(1, 1), a1 + hA, voffA);
            PG8_WAIT_V(8); PG8_WAIT_L(0); PG8_BAR; PG8_MMA(0, 0, At, B0); PG8_MMA(0, 1, At, B1); PG8_BAR; PG8_SCHED;
            PG8_LDA(At, 0, 1); PG8_STAGE(PG8_SB(0, 0), b2, voffB); PG8_STAGE(PG8_SB(0, 1), b2 + hB, voffB); PG8_STAGE(PG8_SA(0, 0), a2, voffA);
            PG8_WAIT_V(8); PG8_WAIT_L(0); PG8_BAR; PG8_MMA(1, 0, At, B0); PG8_MMA(1, 1, At, B1); PG8_BAR; PG8_SCHED;
            PG8_LDB(B0, 1, 0); PG8_LDB(B1, 1, 1); PG8_SCHED; PG8_LDA(At, 1, 0); PG8_STAGE(PG8_SA(0, 1), a2 + hA, voffA);
            PG8_WAIT_V(8); PG8_WAIT_L(0); PG8_BAR; PG8_MMA(0, 0, At, B0); PG8_MMA(0, 1, At, B1); PG8_BAR; PG8_SCHED;
            PG8_LDA(At, 1, 1); PG8_STAGE(PG8_SB(1, 0), b3, voffB); PG8_STAGE(PG8_SB(1, 1), b3 + hB, voffB); PG8_STAGE(PG8_SA(1, 0), a3, voffA);
            PG8_WAIT_V(8); PG8_WAIT_L(0); PG8_BAR; PG8_MMA(1, 0, At, B0); PG8_MMA(1, 1, At, B1); PG8_BAR; PG8_SCHED;
        }
        if (wr == 0) PG8_BAR;
        E(acc, cur, wr, wc, fr, fq);
        if (!has_next) break;
#pragma unroll
        for (int a = 0; a < 2; ++a)
#pragma unroll
            for (int b = 0; b < 2; ++b)
#pragma unroll
                for (int m = 0; m < 4; ++m)
#pragma unroll
                    for (int n = 0; n < 2; ++n) acc[a][b][m][n] = (f32x4){0.f, 0.f, 0.f, 0.f};
        cur = nxt; cA = nA; cB = nB; ++ui;
        if (wr == 1) PG8_BAR;
    }
    PG8_WAIT_V(0);
    PG8_BAR;
#undef PG8_SA
#undef PG8_SB
#undef PG8_STAGE
#undef PG8_LDA
#undef PG8_LDB
#undef PG8_MMA
#undef PG8_WAIT_V
#undef PG8_WAIT_L
#undef PG8_BAR
#undef PG8_SCHED
}

struct EpiSwiGLU {
    static constexpr bool PERM = true;
    bf16_t* O; int ldc;
    __device__ __forceinline__ void operator()(const f32x4 (&acc)[2][2][4][2], const Unit& u, int wr, int wc, int fr, int fq) const {
        const int row0 = u.pm * BM + wr * 64 + fr, col0 = u.pn * HALF + wc * 32 + 8 * fq;
#pragma unroll
        for (int ai = 0; ai < 2; ++ai)
#pragma unroll
            for (int m = 0; m < 4; ++m) {
                bf16_t* rowp = O + (size_t)(row0 + ai * HALF + m * 16) * ldc + col0;
                const f32x4 g0 = acc[ai][0][m][0], g1 = acc[ai][0][m][1], u0 = acc[ai][1][m][0], u1 = acc[ai][1][m][1];
                u32x4 w;
                w.x = cvt_pk_bf16(siluf_(g0[0]) * u0[0], siluf_(g0[1]) * u0[1]); w.y = cvt_pk_bf16(siluf_(g0[2]) * u0[2], siluf_(g0[3]) * u0[3]);
                w.z = cvt_pk_bf16(siluf_(g1[0]) * u1[0], siluf_(g1[1]) * u1[1]); w.w = cvt_pk_bf16(siluf_(g1[2]) * u1[2], siluf_(g1[3]) * u1[3]);
                *(u32x4*)rowp = w;
            }
    }
};
struct EpiResid {
    static constexpr bool PERM = false;
    const float* base_lat; const float* base_ctx; float* out_lat; float* out_ctx; const float* gate; float s;
    __device__ __forceinline__ void operator()(const f32x4 (&acc)[2][2][4][2], const Unit& u, int wr, int wc, int fr, int fq) const {
        const bool lat = u.pm < 64;
        const float* base = lat ? base_lat + (size_t)u.pm * BM * DM : base_ctx + (size_t)(u.pm - 64) * BM * DM;
        float* out = lat ? out_lat + (size_t)u.pm * BM * DM : out_ctx + (size_t)(u.pm - 64) * BM * DM;
        const float* grow = gate + (size_t)(lat ? (u.pm >> 4) : 4) * NMODC;
        const int col0 = u.pn * BM + wc * 32 + 4 * fq;
#pragma unroll
        for (int bj = 0; bj < 2; ++bj)
#pragma unroll
            for (int n = 0; n < 2; ++n) {
                const int col = col0 + bj * HALF + n * 16;
                const f32x4 gv = *(const f32x4*)(grow + col) * s;
#pragma unroll
                for (int ai = 0; ai < 2; ++ai)
#pragma unroll
                    for (int m = 0; m < 4; ++m) {
                        const size_t off = (size_t)(ai * HALF + wr * 64 + m * 16 + fr) * DM + col;
                        const f32x4 bs = *(const f32x4*)(base + off);
                        *(f32x4*)(out + off) = bs + gv * acc[ai][bj][m][n];
                    }
            }
    }
};
struct EpiInProj {
    static constexpr bool PERM = true;
    bf16_t *Q, *K, *V, *LX, *LG, *GA, *GL;
    __device__ __forceinline__ void operator()(const f32x4 (&acc)[2][2][4][2], const Unit& u, int wr, int wc, int fr, int fq) const {
        const int pn = u.pn, pm = u.pm;
        bf16_t* base; int ld, ct; bool all_rows = false, kv = false;
        if (pn < 8) { base = Q; ld = DM; ct = pn; }
        else if (pn < 10) { base = K; ld = KVW; ct = pn - 8; kv = true; all_rows = true; }
        else if (pn < 12) { base = V; ld = KVW; ct = pn - 10; kv = true; all_rows = true; }
        else if (pn < 20) { base = LX; ld = DM; ct = pn - 12; all_rows = true; }
        else if (pn < 28) { base = LG; ld = DM; ct = pn - 20; }
        else if (pn < 36) { base = GA; ld = DM; ct = pn - 28; }
        else { base = GL; ld = DM; ct = pn - 36; }
        if (!all_rows && pm >= 64) return;
        int rowbase = pm * BM;
        if (kv) rowbase = pm < 64 ? (pm >> 4) * SKV + CTXL + (pm & 15) * BM : (pm - 64) * SKV;
        const int row0 = rowbase + wr * 64 + fr, col0 = ct * BM + wc * 32 + 8 * fq;
#pragma unroll
        for (int ai = 0; ai < 2; ++ai)
#pragma unroll
            for (int m = 0; m < 4; ++m) {
                bf16_t* rowp = base + (size_t)(row0 + ai * HALF + m * 16) * ld + col0;
#pragma unroll
                for (int bj = 0; bj < 2; ++bj) {
                    const f32x4 v0 = acc[ai][bj][m][0], v1 = acc[ai][bj][m][1];
                    u32x4 w; w.x = cvt_pk_bf16(v0[0], v0[1]); w.y = cvt_pk_bf16(v0[2], v0[3]); w.z = cvt_pk_bf16(v1[0], v1[1]); w.w = cvt_pk_bf16(v1[2], v1[3]);
                    *(u32x4*)(rowp + bj * HALF) = w;
                }
            }
    }
};
struct EpiLru {
    static constexpr bool PERM = true;
    const bf16_t* XC; bf16_t *LAf, *Uf, *LAb, *Ub; const float *ba, *bx, *lam;
    __device__ __forceinline__ void operator()(const f32x4 (&acc)[2][2][4][2], const Unit& u, int wr, int wc, int fr, int fq) const {
        const int nb = u.pn >> 1, dir = u.pn & 1;
        const int ch0 = nb * 128 + wc * 32 + 8 * fq;
        bf16_t* LA = dir ? LAb : LAf; bf16_t* U = dir ? Ub : Uf;
        float cba[8], cbx[8], csp[8];
#pragma unroll
        for (int e = 0; e < 8; ++e) { cba[e] = ba[dir * DM + ch0 + e]; cbx[e] = bx[dir * DM + ch0 + e];
            const float l = lam[dir * DM + ch0 + e]; csp[e] = -8.0f * __logf(1.0f + __expf(-l)); }
        const int row0 = u.pm * BM + wr * 64 + fr;
#pragma unroll
        for (int ai = 0; ai < 2; ++ai)
#pragma unroll
            for (int m = 0; m < 4; ++m) {
                const size_t off = (size_t)(row0 + ai * HALF + m * 16) * DM + ch0;
                float xv[8]; unpack8(*(const u32x4*)(XC + off), xv);
                float la[8], uu[8];
#pragma unroll
                for (int e = 0; e < 8; ++e) {
                    const float za = acc[ai][0][m][e >> 2][e & 3] + cba[e], zx = acc[ai][1][m][e >> 2][e & 3] + cbx[e];
                    const float r = sigmoidf_(za), ig = sigmoidf_(zx);
                    const float l = csp[e] * r;
                    const float y = 2.0f * l;
                    const float em = (y > -0.02f) ? -y * (1.0f + 0.5f * y * (1.0f + 0.33333333f * y)) : 1.0f - expf_(y);
                    la[e] = l; uu[e] = __builtin_sqrtf(em) * ig * xv[e];
                }
                *(u32x4*)(LA + off) = pack8(la); *(u32x4*)(U + off) = pack8(uu);
            }
    }
};
}

namespace att {
#ifndef ATT_SDEPTH
#define ATT_SDEPTH 1
#endif
constexpr int D = 128, NW = 8, QBLK = 32, KVBLK = 64;
constexpr float SCALE = 0.088388347648318440f;
constexpr float THR = 8.f;
constexpr int LDQ = DM, LDK = KVW, LDO = DM;
constexpr size_t SHM_V = KVBLK * D * 2, SHM_K = KVBLK * D * 2, SHM_ATTN = 2 * SHM_V + 2 * SHM_K + NW * 64 * 4;
#define KSWZ(row, colB) ((row) * 256 + ((colB) ^ (((row) & 7) << 4)))
#define SBAR() __builtin_amdgcn_sched_barrier(0)
__device__ __forceinline__ int crow(int r, int hi) { return (r & 3) + 8 * (r >> 2) + 4 * hi; }
__device__ __forceinline__ void partialSM(f32x16& p0, f32x16& p1, float& m_reg, float& mn, float& alpha) {
  constexpr float C = SCALE * 1.4426950408889634f;
  float pmax = p0[0]; for (int r = 1; r < 16; ++r) pmax = fmaxf(pmax, p0[r]); for (int r = 0; r < 16; ++r) pmax = fmaxf(pmax, p1[r]);
  { auto rr = __builtin_amdgcn_permlane32_swap(__float_as_uint(pmax), __float_as_uint(pmax), false, false);
    pmax = fmaxf(__uint_as_float(rr[0]), __uint_as_float(rr[1])); }
  if (__builtin_expect(__all(pmax - m_reg <= THR / SCALE), 1)) { mn = m_reg; alpha = 1.f; }
  else { mn = fmaxf(m_reg, pmax); alpha = __builtin_amdgcn_exp2f((m_reg - mn) * C); m_reg = mn; }
  float mnC = -mn * C;
  for (int r = 0; r < 16; ++r) p0[r] = fmaf(p0[r], C, mnC); for (int r = 0; r < 16; ++r) p1[r] = fmaf(p1[r], C, mnC);
  for (int r = 0; r < 16; ++r) p0[r] = __builtin_amdgcn_exp2f(p0[r]);
}
__device__ __forceinline__ void finishSM(f32x16& p0, f32x16& p1, float alpha, float& l_reg, bf16x8& pa0, bf16x8& pa1, bf16x8& pa2, bf16x8& pa3) {
  for (int r = 0; r < 16; ++r) p1[r] = __builtin_amdgcn_exp2f(p1[r]);
  float ps = 0; for (int r = 0; r < 16; ++r) ps += p0[r]; for (int r = 0; r < 16; ++r) ps += p1[r];
  { auto rr = __builtin_amdgcn_permlane32_swap(__float_as_uint(ps), __float_as_uint(ps), false, false);
    ps = __uint_as_float(rr[0]) + __uint_as_float(rr[1]); }
  l_reg = l_reg * alpha + ps;
#define PK4(P, BASE, OUT) do { unsigned a0 = cvt_pk_bf16(P[BASE + 0], P[BASE + 1]), a1 = cvt_pk_bf16(P[BASE + 2], P[BASE + 3]);   \
    unsigned b0 = cvt_pk_bf16(P[BASE + 4], P[BASE + 5]), b1 = cvt_pk_bf16(P[BASE + 6], P[BASE + 7]);                              \
    auto r0 = __builtin_amdgcn_permlane32_swap(a0, b0, false, false); auto r1 = __builtin_amdgcn_permlane32_swap(a1, b1, false, false); \
    u32x4 w = {r0[0], r1[0], r0[1], r1[1]}; OUT = *reinterpret_cast<bf16x8*>(&w); } while (0)
  PK4(p0, 0, pa0); PK4(p0, 8, pa1); PK4(p1, 0, pa2); PK4(p1, 8, pa3);
#undef PK4
}
__device__ __forceinline__ void qkt(f32x16& p0, f32x16& p1, const bf16_t* Ks, const char* Qs, int r32, int hi) {
  p0 = f32x16{}; p1 = f32x16{};
  for (int d0 = 0; d0 < 8; ++d0) { int cb = (d0 * 16 + hi * 8) * 2;
    bf16x8 b0 = *reinterpret_cast<const bf16x8*>((const char*)Ks + KSWZ(r32, cb));
    bf16x8 b1 = *reinterpret_cast<const bf16x8*>((const char*)Ks + KSWZ(32 + r32, cb));
    bf16x8 qf = *reinterpret_cast<const bf16x8*>(Qs + KSWZ(r32, cb));
    p0 = __builtin_amdgcn_mfma_f32_32x32x16_bf16(b0, qf, p0, 0, 0, 0);
    p1 = __builtin_amdgcn_mfma_f32_32x32x16_bf16(b1, qf, p1, 0, 0, 0); }
}
__device__ __forceinline__ int v_st(int k, int c) { const int kk = (k & ~0xC) | ((k & 4) << 1) | ((k & 8) >> 1); return ((kk >> 3) * 4 + (c >> 5)) * 512 + ((kk & 7) * 32 + (c & 31)) * 2; }
__device__ __forceinline__ int v_rd_base(int lane) { return ((lane & 3) << 3) | (((lane >> 2) & 3) << 6) | (((lane >> 4) & 1) << 5) | (((lane >> 5) & 1) << 8); }
constexpr int v_rd_off(int d0, int ks, int half) { return d0 * 512 + ks * 4096 + half * 2048; }
template <int OFF> __device__ __forceinline__ s16x4 tr_read(int vb) {
  s16x4 r; asm volatile("ds_read_b64_tr_b16 %0, %1 offset:%2" : "=&v"(r) : "v"(vb), "i"(OFF) : "memory"); return r;
}
template <int D0> __device__ __forceinline__ void pv_one(f32x16& od, int vb, bf16x8 pa0, bf16x8 pa1, bf16x8 pa2, bf16x8 pa3) {
  const s16x4 l0 = tr_read<v_rd_off(D0, 0, 0)>(vb), h0 = tr_read<v_rd_off(D0, 0, 1)>(vb), l1 = tr_read<v_rd_off(D0, 1, 0)>(vb), h1 = tr_read<v_rd_off(D0, 1, 1)>(vb);
  const s16x4 l2 = tr_read<v_rd_off(D0, 2, 0)>(vb), h2 = tr_read<v_rd_off(D0, 2, 1)>(vb), l3 = tr_read<v_rd_off(D0, 3, 0)>(vb), h3 = tr_read<v_rd_off(D0, 3, 1)>(vb);
  asm volatile("s_waitcnt lgkmcnt(0)" ::: "memory"); SBAR();
#define PK(L, H) (bf16x8){L[0], L[1], L[2], L[3], H[0], H[1], H[2], H[3]}
  od = __builtin_amdgcn_mfma_f32_32x32x16_bf16(pa0, PK(l0, h0), od, 0, 0, 0);
  od = __builtin_amdgcn_mfma_f32_32x32x16_bf16(pa1, PK(l1, h1), od, 0, 0, 0);
  od = __builtin_amdgcn_mfma_f32_32x32x16_bf16(pa2, PK(l2, h2), od, 0, 0, 0);
  od = __builtin_amdgcn_mfma_f32_32x32x16_bf16(pa3, PK(l3, h3), od, 0, 0, 0);
#undef PK
}
__device__ __forceinline__ void pv_d0(f32x16* o, int vb, bf16x8 pa0, bf16x8 pa1, bf16x8 pa2, bf16x8 pa3) {
  pv_one<0>(o[0], vb, pa0, pa1, pa2, pa3); pv_one<1>(o[1], vb, pa0, pa1, pa2, pa3); pv_one<2>(o[2], vb, pa0, pa1, pa2, pa3); pv_one<3>(o[3], vb, pa0, pa1, pa2, pa3);
}
__device__ __forceinline__ void attn_dense_body(const bf16_t* Qb, const bf16_t* __restrict__ Kh, const bf16_t* __restrict__ Vh,
                                                bf16_t* Ob, const bf16_t* Gb, int seq, char* lds) {
  int tid = threadIdx.x; asm volatile("" : "+v"(tid));
  const int wid = tid >> 6, lane = tid & 63, r32 = lane & 31, hi = lane >> 5;
  bf16_t* V_lds = (bf16_t*)lds; bf16_t* K_lds = (bf16_t*)(lds + 2 * SHM_V);
  float* ws = (float*)(lds + 2 * SHM_V + 2 * SHM_K) + wid * 64; float* li_l = ws; float* al_l = ws + 32;
  float m_reg = -1e30f, l_reg = 0; f32x16 o[4] = {};
  char* const qr = lds + 69632 + wid * 8192;
  const bf16_t* Qw = Qb + (long)(wid * QBLK + r32) * LDQ + hi * 8;
#pragma unroll
  for (int d0 = 0; d0 < 8; ++d0) *reinterpret_cast<bf16x8*>(qr + KSWZ(r32, (d0 * 16 + hi * 8) * 2)) = *reinterpret_cast<const bf16x8*>(Qw + d0 * 16);
  const int sr = tid >> 4, sc = (tid & 15) * 8, vst0 = v_st(sr, sc), vst1 = v_st(32 + sr, sc);
  const int vb0 = (int)(uintptr_t)V_lds + v_rd_base(lane);
  constexpr int SDEPTH = ATT_SDEPTH;
  struct { bf16x8 vs0, vs1, ks0, ks1; } sr_[SDEPTH];
#define LD8(p) (*reinterpret_cast<const bf16x8*>(p))
#define SLOAD(i, k0) do { sr_[i].vs0 = LD8(&Vh[(long)((k0) + sr) * LDK + sc]); sr_[i].vs1 = LD8(&Vh[(long)((k0) + 32 + sr) * LDK + sc]); \
    sr_[i].ks0 = LD8(&Kh[(long)((k0) + sr) * LDK + sc]); sr_[i].ks1 = LD8(&Kh[(long)((k0) + 32 + sr) * LDK + sc]); } while (0)
#define SWRITE(b, i) do { *(bf16x8*)((char*)V_lds + (b) * SHM_V + vst0) = sr_[i].vs0;          \
    *(bf16x8*)((char*)V_lds + (b) * SHM_V + vst1) = sr_[i].vs1; int kc = sc * 2;               \
    *(bf16x8*)((char*)K_lds + (b) * SHM_K + KSWZ(sr, kc)) = sr_[i].ks0;                       \
    *(bf16x8*)((char*)K_lds + (b) * SHM_K + KSWZ(32 + sr, kc)) = sr_[i].ks1; } while (0)
#define SWAIT() do { if constexpr (SDEPTH == 2) asm volatile("s_waitcnt vmcnt(4)" ::: "memory"); else asm volatile("s_waitcnt vmcnt(0)" ::: "memory"); } while (0)
#define RESC(a) do { if (__any((a) < 1.f)) { if (hi == 0) al_l[r32] = (a); asm volatile("s_waitcnt lgkmcnt(0)" ::: "memory"); \
    for (int d = 0; d < 4; ++d) for (int r = 0; r < 16; ++r) o[d][r] *= al_l[crow(r, hi)]; } } while (0)
  f32x16 pA0, pA1, pB0, pB1; float mnA, mnB, alA, alB; bf16x8 pa0, pa1, pa2, pa3; const int NT = seq / KVBLK;
  constexpr int SE = 0, SO = SDEPTH - 1;
  SLOAD(SE, 0); asm volatile("s_waitcnt vmcnt(0)" ::: "memory"); SWRITE(0, SE); __syncthreads();
  qkt(pA0, pA1, K_lds, qr, r32, hi); partialSM(pA0, pA1, m_reg, mnA, alA);
  SLOAD(SO, KVBLK); if constexpr (SDEPTH == 2) { if (2 < NT) SLOAD(SE, 2 * KVBLK); }
  SWAIT(); SWRITE(1, SO); __syncthreads();
  for (int j = 1; j + 1 < NT; j += 2) {
    SBAR(); qkt(pB0, pB1, (bf16_t*)((char*)K_lds + SHM_K), qr, r32, hi);
    finishSM(pA0, pA1, alA, l_reg, pa0, pa1, pa2, pa3); SBAR();
    SLOAD(SO, (j + SDEPTH) * KVBLK); SBAR();
    pv_d0(o, vb0, pa0, pa1, pa2, pa3); partialSM(pB0, pB1, m_reg, mnB, alB);
    __syncthreads(); SWAIT(); SWRITE(0, SE);
    RESC(alB); __syncthreads();
    SBAR(); qkt(pA0, pA1, K_lds, qr, r32, hi);
    finishSM(pB0, pB1, alB, l_reg, pa0, pa1, pa2, pa3); SBAR();
    if (SDEPTH == 1 || j + 3 < NT) SLOAD(SE, (j + 1 + SDEPTH) * KVBLK); SBAR();
    pv_d0(o, vb0 + (int)SHM_V, pa0, pa1, pa2, pa3); partialSM(pA0, pA1, m_reg, mnA, alA);
    __syncthreads(); SWAIT(); SWRITE(1, SO);
    RESC(alA); __syncthreads();
  }
  SBAR(); qkt(pB0, pB1, (bf16_t*)((char*)K_lds + SHM_K), qr, r32, hi);
  finishSM(pA0, pA1, alA, l_reg, pa0, pa1, pa2, pa3); SBAR();
  pv_d0(o, vb0, pa0, pa1, pa2, pa3); partialSM(pB0, pB1, m_reg, mnB, alB);
  __syncthreads(); RESC(alB);
  finishSM(pB0, pB1, alB, l_reg, pa0, pa1, pa2, pa3); SBAR();
  pv_d0(o, vb0 + (int)SHM_V, pa0, pa1, pa2, pa3);
  if (hi == 0) li_l[r32] = l_reg; asm volatile("s_waitcnt lgkmcnt(0)" ::: "memory");
  float rli[16];
#pragma unroll
  for (int r = 0; r < 16; ++r) rli[r] = __builtin_amdgcn_rcpf(li_l[crow(r, hi)]);
  bf16_t* Ow = Ob + (long)(wid * QBLK) * LDO; const bf16_t* Gw = Gb + (long)(wid * QBLK) * LDO;
#pragma unroll
  for (int r = 0; r < 16; ++r) { int orow = crow(r, hi);
#pragma unroll
    for (int d0 = 0; d0 < 4; ++d0) { const long idx = (long)orow * LDO + d0 * 32 + r32;
      Ow[idx] = f2bf(o[d0][r] * rli[r]); }
    asm volatile("" ::: "memory"); }
  asm volatile("s_waitcnt vmcnt(0)" ::: "memory");
#pragma unroll 2
  for (int r = 0; r < 16; ++r) { int orow = crow(r, hi);
#pragma unroll
    for (int d0 = 0; d0 < 4; ++d0) { const long idx = (long)orow * LDO + d0 * 32 + r32;
      Ow[idx] = f2bf(bf2f(Ow[idx]) * sigmoidf_(bf2f(Gw[idx]))); }
    asm volatile("" ::: "memory"); }
#undef LD8
#undef SLOAD
#undef SWRITE
#undef SWAIT
#undef RESC
}
}

__device__ __forceinline__ void transpose_item(const float* W, int ldw, int k0, int n0, bf16_t* WT, int ldt, int drow0, LAS float* scr, int lane) {
#pragma unroll 8
    for (int i = 0; i < 32; ++i) { const int kk = 2 * i + (lane >> 5); scr[kk * 33 + (lane & 31)] = W[(size_t)(k0 + kk) * ldw + n0 + (lane & 31)]; }
    asm volatile("s_waitcnt lgkmcnt(0)" ::: "memory");
    const int c = lane & 7;
#pragma unroll
    for (int j = 0; j < 4; ++j) { const int n = (lane >> 3) + 8 * j; const LAS float* s = scr + (8 * c) * 33 + n;
        u32x4 o; o.x = cvt_pk_bf16(s[0 * 33], s[1 * 33]); o.y = cvt_pk_bf16(s[2 * 33], s[3 * 33]); o.z = cvt_pk_bf16(s[4 * 33], s[5 * 33]); o.w = cvt_pk_bf16(s[6 * 33], s[7 * 33]);
        *(u32x4*)(WT + (size_t)(drow0 + n) * ldt + k0 + 8 * c) = o; }
    asm volatile("s_waitcnt lgkmcnt(0)" ::: "memory");
}
__device__ __forceinline__ void convert_ffn(const float* wg, const float* wu, const float* wd, bf16_t* Wgu, bf16_t* Wd, LAS float* scr, int gw, int NGW, int lane) {
    constexpr int I_G = 32 * 176, I_D = 88 * 64;
    for (int it = gw; it < 2 * I_G + I_D; it += NGW) {
        if (it < 2 * I_G) { const int which = it >= I_G, r = which ? it - I_G : it; const int kb = r / 176, nb = r % 176, n0 = nb * 32;
            transpose_item(which ? wu : wg, DFF, kb * 64, n0, Wgu, DM, (n0 >> 7) * 256 + (n0 & 127) + which * 128, scr, lane); }
        else { const int r = it - 2 * I_G; const int kb = r / 64, nb = r % 64;
            transpose_item(wd, DM, kb * 64, nb * 32, Wd, DFF, nb * 32, scr, lane); }
    }
}

__device__ __forceinline__ void norm_mod_rows(const float* xlat, const float* xctx, int nrows, const float* g, const float* mod, int shi, bf16_t* H, int gw, int NGW, int lane) {
    for (int m = gw; m < nrows; m += NGW) {
        const bool lat = m < MLAT;
        const float* xr = lat ? xlat + (size_t)m * DM : xctx + (size_t)(m - MLAT) * DM;
        const float* mr = mod + (size_t)(lat ? (m >> 12) : 4) * NMODC + shi * DM;
        f32x4 v[8]; float s = 0.f;
#pragma unroll
        for (int j = 0; j < 8; ++j) { v[j] = ((const f32x4*)xr)[lane + 64 * j]; s += v[j].x * v[j].x + v[j].y * v[j].y + v[j].z * v[j].z + v[j].w * v[j].w; }
        const float rstd = 1.0f / sqrtf(wave_sum(s) * (1.0f / DM) + EPS);
#pragma unroll
        for (int j = 0; j < 8; ++j) {
            const int c4 = lane + 64 * j;
            const f32x4 gg = ((const f32x4*)g)[c4], sh = ((const f32x4*)mr)[c4], sc = ((const f32x4*)(mr + DM))[c4];
            const f32x4 y = v[j] * rstd * gg * (sc + 1.0f) + sh;
            u32x2 w; w.x = cvt_pk_bf16(y.x, y.y); w.y = cvt_pk_bf16(y.z, y.w);
            ((u32x2*)(H + (size_t)m * DM))[c4] = w;
        }
    }
}

#ifndef PH_MASK
#define PH_MASK 0xFFFFFFu
#endif
#define PH(n) (((PH_MASK) >> (n)) & 1u)
struct Args { const float* in[22]; float* out; unsigned char* ws; };


typedef __attribute__((address_space(4))) const unsigned long long* kargp_t;
__device__ __forceinline__ unsigned long long kload(int i) {
    unsigned long long p = (unsigned long long)__builtin_amdgcn_kernarg_segment_ptr();
    asm volatile("" : "+s"(p));
    const unsigned long long v = ((kargp_t)p)[i];
    const unsigned lo = __builtin_amdgcn_readfirstlane((unsigned)v), hi = __builtin_amdgcn_readfirstlane((unsigned)(v >> 32));
    return ((unsigned long long)hi << 32) | lo;
}
#define GAS __attribute__((address_space(1)))
#define INP(i) ((const float*)(GAS const float*)kload(i))
#define wsb ((GAS unsigned char*)kload(23))
#define outp ((float*)(GAS float*)kload(22))
#define xin INP(0)
#define cvec INP(1)
#define ctx INP(2)
#define c_ctx INP(3)
#define w_mod INP(4)
#define b_mod INP(5)
#define norm_g INP(6)
#define ffn_wg INP(7)
#define ffn_wu INP(8)
#define ffn_wd INP(9)
#define w_in INP(10)
#define w_out INP(11)
#define q_norm_g INP(12)
#define k_norm_g INP(13)
#define conv_w INP(14)
#define conv_b INP(15)
#define lru_wa INP(16)
#define lru_ba INP(17)
#define lru_wx INP(18)
#define lru_bx INP(19)
#define lru_lambda INP(20)
#define final_g INP(21)
#define MOD ((float*)(GAS float*)(wsb + WS_MOD))
#define MODP ((float*)(GAS float*)(wsb + WS_MODP))
#define CA ((float*)(GAS float*)(wsb + WS_CA))
#define CB ((float*)(GAS float*)(wsb + WS_CB))
#define SS ((float*)(GAS float*)(wsb + WS_SS))
#define XC1 ((float*)(GAS float*)(wsb + WS_XC1))
#define Wout_t ((bf16_t*)(GAS bf16_t*)(wsb + WS_WOUT))
#define Wlru_t ((bf16_t*)(GAS bf16_t*)(wsb + WS_WLRU))
#define Wgu_t ((bf16_t*)(GAS bf16_t*)(wsb + WS_WGU))
#define Wd_t ((bf16_t*)(GAS bf16_t*)(wsb + WS_WD))
#define Win_t ((bf16_t*)(GAS bf16_t*)(wsb + WS_WIN))
#define H ((bf16_t*)(GAS bf16_t*)(wsb + WS_H))
#define ACT ((bf16_t*)(GAS bf16_t*)(wsb + WS_ACT))
#define Qb ((bf16_t*)(GAS bf16_t*)(wsb + WS_Q))
#define GAb ((bf16_t*)(GAS bf16_t*)(wsb + WS_GA))
#define Kb ((bf16_t*)(GAS bf16_t*)(wsb + WS_K))
#define Vb ((bf16_t*)(GAS bf16_t*)(wsb + WS_V))
#define LXb ((bf16_t*)(GAS bf16_t*)(wsb + WS_LX))
#define LGb ((bf16_t*)(GAS bf16_t*)(wsb + WS_LG))
#define GLb ((bf16_t*)(GAS bf16_t*)(wsb + WS_GL))
#define LAf ((bf16_t*)(GAS bf16_t*)(wsb + WS_LAF))
#define Uf ((bf16_t*)(GAS bf16_t*)(wsb + WS_UF))
#define LAb ((bf16_t*)(GAS bf16_t*)(wsb + WS_LAB))
#define Ub ((bf16_t*)(GAS bf16_t*)(wsb + WS_UB))

__global__ void __launch_bounds__(NTHR, 2) mk_fwd(Args args) {
    extern __shared__ __attribute__((aligned(16))) unsigned char lds[];
    cg::grid_group grid = cg::this_grid();
    LAS unsigned char* L = (LAS unsigned char*)lds;
    const int G = gridDim.x, bx = blockIdx.x;
#define IDS() int tid = threadIdx.x; asm volatile("" : "+v"(tid)); const int lane = tid & 63, wave = __builtin_amdgcn_readfirstlane(tid >> 6); \
    const int gw = bx * NWAVES + wave, NGW = G * NWAVES; const int gt = bx * NTHR + tid, NGT = G * NTHR; LAS float* scr = (LAS float*)(L + wave * 16384); \
    (void)lane; (void)gw; (void)NGW; (void)gt; (void)NGT; (void)scr;

    if (PH(0))
    { IDS();
        for (int it = gw; it < 72 * 32; it += NGW) {
            const int jb = it % 72, kc = it / 72, j0 = jb * 256 + 4 * lane, k0 = kc * 64;
            float s[5];
#pragma unroll
            for (int r = 0; r < 5; ++r) { const float cv = r < 4 ? cvec[r * DM + k0 + lane] : c_ctx[k0 + lane]; s[r] = siluf_(cv); }
            f32x4 acc[5];
#pragma unroll
            for (int r = 0; r < 5; ++r) acc[r] = (f32x4){0.f, 0.f, 0.f, 0.f};
#pragma unroll 8
            for (int k = 0; k < 64; ++k) {
                const f32x4 w = *(const f32x4*)(w_mod + (size_t)(k0 + k) * NMODC + j0);
#pragma unroll
                for (int r = 0; r < 5; ++r) { const float sr = __uint_as_float(__builtin_amdgcn_readlane(__float_as_uint(s[r]), k)); acc[r] += w * sr; }
            }
#pragma unroll
            for (int r = 0; r < 5; ++r) *(f32x4*)(MODP + (size_t)(kc * 5 + r) * NMODC + j0) = acc[r];
        }
        convert_ffn(ffn_wg, ffn_wu, ffn_wd, Wgu_t, Wd_t, scr, gw, NGW, lane);
        constexpr int I_IN = 32 * 352, I_OUT = 32 * 64, I_LRU = 64 * 8;
        for (int it = gw; it < I_IN + I_OUT + I_LRU; it += NGW) {
            if (it < I_IN) { const int kb = it / 352, nb = it % 352; transpose_item(w_in, INW, kb * 64, nb * 32, Win_t, DM, nb * 32, scr, lane); }
            else if (it < I_IN + I_OUT) { const int r = it - I_IN, kb = r / 64, nb = r % 64; transpose_item(w_out, DM, kb * 64, nb * 32, Wout_t, DM, nb * 32, scr, lane); }
            else { const int r = it - I_IN - I_OUT, mat = r >> 3, sub = r & 7, kb = sub >> 2, nb4 = sub & 3;
                const int which = mat >> 5, dir = (mat >> 4) & 1, nb = mat & 15;
                const float* src = (which ? lru_wx : lru_wa) + (size_t)(dir * 16 + nb) * 128 * 128;
                transpose_item(src, 128, kb * 64, nb4 * 32, Wlru_t, 128, (nb * 2 + dir) * 256 + which * 128 + nb4 * 32, scr, lane); }
        }
    }
    grid.sync();
    if (PH(0))
    { IDS();
    for (int idx = gt; idx < 5 * (NMODC / 4); idx += NGT) {
        const int r = idx / (NMODC / 4), j4 = idx % (NMODC / 4);
        f32x4 sacc = ((const f32x4*)b_mod)[j4];
        for (int kc = 0; kc < 32; ++kc) sacc += ((const f32x4*)(MODP + (size_t)(kc * 5 + r) * NMODC))[j4];
        ((f32x4*)(MOD + (size_t)r * NMODC))[j4] = sacc;
    }
    }
    grid.sync();
    if (PH(1))
    { IDS();
    norm_mod_rows(xin, ctx, MALL, norm_g, MOD, 0, H, gw, NGW, lane);
    }
    grid.sync();
    if (PH(2))
    { IDS();
        pg8::Gemm g{H, Wgu_t, DM, DM, DM}; pg8::StaticOrder S; S.init(MALL, NGU, G, bx);
        pg8::EpiSwiGLU E{ACT, DFF};
        pg8::gemm_phase<pg8::EpiSwiGLU, pg8::StaticOrder>(L, g, S, E);
    }
    grid.sync();
    if (PH(3))
    { IDS();
        pg8::Gemm g{ACT, Wd_t, DFF, DFF, DFF}; pg8::StaticOrder S; S.init(MALL, DM, G, bx);
        pg8::EpiResid E{xin, ctx, outp, XC1, MOD + 2 * DM, 0.5f};
        pg8::gemm_phase<pg8::EpiResid, pg8::StaticOrder>(L, g, S, E);
    }
    grid.sync();
    if (PH(4))
    { IDS();
    norm_mod_rows(outp, XC1, MALL, norm_g + DM, MOD, 3, H, gw, NGW, lane);
    }
    grid.sync();
    if (PH(5))
    { IDS();
        pg8::Gemm g{H, Win_t, DM, DM, DM}; pg8::StaticOrder S; S.init(MALL, INW, G, bx);
        pg8::EpiInProj E{Qb, Kb, Vb, LXb, LGb, GAb, GLb};
        pg8::gemm_phase<pg8::EpiInProj, pg8::StaticOrder>(L, g, S, E);
    }
    grid.sync();
    if (PH(6))
    { IDS();
        bf16_t* XC = H;
        const int l16 = lane & 15;
        float gq[8], gk[8];
#pragma unroll
        for (int e = 0; e < 8; ++e) { gq[e] = q_norm_g[l16 * 8 + e]; gk[e] = k_norm_g[l16 * 8 + e]; }
        for (int m = gw; m < MALL; m += NGW) {
            const bool lat = m < MLAT;
            const int t = lat ? (m & (SEQ - 1)) : ((m - MLAT) & (CTXL - 1));
            const int b = lat ? (m >> 12) : ((m - MLAT) >> 8);
            float cs[4], sn[4];
#pragma unroll
            for (int p = 0; p < 4; ++p) { const int i = l16 * 4 + p; const int pos = (i < 32) ? (t >> 6) : (t & 63); const int j = i & 31;
                const float freq = __builtin_amdgcn_exp2f(-(float)j * (13.287712379549449f / 32.0f)); const float ang = (float)pos * freq;
                cs[p] = lat ? __cosf(ang) : 1.0f; sn[p] = lat ? __sinf(ang) : 0.0f; }
            const int kvrow = lat ? b * SKV + CTXL + t : b * SKV + t;
#pragma unroll
            for (int a = 0; a < 5; ++a) {
                if (a < 4 && !lat) continue;
                bf16_t* p = (a < 4) ? Qb + (size_t)m * DM + a * 512 + lane * 8 : Kb + (size_t)kvrow * KVW + lane * 8;
                float xv[8]; unpack8(*(const u32x4*)p, xv);
                float ss = 0.f;
#pragma unroll
                for (int e = 0; e < 8; ++e) ss += xv[e] * xv[e];
                ss += __shfl_xor(ss, 1); ss += __shfl_xor(ss, 2); ss += __shfl_xor(ss, 4); ss += __shfl_xor(ss, 8);
                const float rs = 1.0f / sqrtf(ss * (1.0f / 128.0f) + EPS);
                float y[8];
#pragma unroll
                for (int e = 0; e < 8; ++e) y[e] = xv[e] * rs * (a < 4 ? gq[e] : gk[e]);
#pragma unroll
                for (int pp = 0; pp < 4; ++pp) { const float y0 = y[2 * pp], y1 = y[2 * pp + 1]; y[2 * pp] = y0 * cs[pp] - y1 * sn[pp]; y[2 * pp + 1] = y0 * sn[pp] + y1 * cs[pp]; }
                *(u32x4*)p = pack8(y);
            }
            const int len = lat ? SEQ : CTXL;
#pragma unroll
            for (int a = 0; a < 4; ++a) {
                const int col = a * 512 + lane * 8;
                float acc[8];
#pragma unroll
                for (int e = 0; e < 8; ++e) acc[e] = conv_b[col + e];
#pragma unroll
                for (int d = 0; d < 4; ++d) {
                    const int tt = t + d - 2;
                    if (tt >= 0 && tt < len) {
                        float xv[8]; unpack8(*(const u32x4*)(LXb + (size_t)(m + d - 2) * DM + col), xv);
#pragma unroll
                        for (int e = 0; e < 8; ++e) acc[e] += xv[e] * conv_w[d * DM + col + e];
                    }
                }
                *(u32x4*)(XC + (size_t)m * DM + col) = pack8(acc);
            }
        }
    }
    grid.sync();
    if (PH(7))
    { IDS();
        bf16_t* const q_ = Qb; const bf16_t* const k_ = Kb; const bf16_t* const v_ = Vb; const bf16_t* const g_ = GAb;
#pragma unroll 1
        for (int i = 0; i < 4; ++i) {
            const int xcd = bx & 7, cu = bx >> 3;
            const int pair = xcd * 2 + (i >> 1), idx = (i & 1) * 32 + cu;
            if (G != 256) break;
            const int b = pair >> 2, kvh = pair & 3, qh = kvh * 4 + (idx >> 4), qb = idx & 15;
            const size_t qoff = ((size_t)b * SEQ + qb * 256) * DM + qh * 128;
            const size_t koff = (size_t)b * SKV * KVW + kvh * 128;
            att::attn_dense_body(q_ + qoff, k_ + koff, v_ + koff, q_ + qoff, g_ + qoff, SKV, (char*)lds);
            __syncthreads();
        }
    }
    grid.sync();
    if (PH(8))
    { IDS();
        pg8::Gemm g{H, Wlru_t, DM, 128, 128}; pg8::LruOrder S{G, bx};
        pg8::EpiLru E{H, LAf, Uf, LAb, Ub, lru_ba, lru_bx, lru_lambda};
        pg8::gemm_phase<pg8::EpiLru, pg8::LruOrder>(L, g, S, E);
    }
    grid.sync();
    if (PH(9))
    { IDS();
        for (int it = bx; it < 2 * 4 * 68 * 2; it += G) {
            const int half = it & 1, q = it >> 1, p = q % 68, db = q / 68, b = db & 3, dir = db >> 2;
            const int cp = half * 512 + tid;
            int rowc;
            if (dir == 0) rowc = (p < 4) ? MLAT + b * CTXL + p * 64 : b * SEQ + (p - 4) * 64;
            else rowc = (p < 4) ? MLAT + b * CTXL + (3 - p) * 64 : b * SEQ + (67 - p) * 64;
            const unsigned* LA = (const unsigned*)(dir ? LAb : LAf); const unsigned* U = (const unsigned*)(dir ? Ub : Uf);
            float s0 = 0.f, s1 = 0.f, h0 = 0.f, h1 = 0.f;
#pragma unroll 8
            for (int s = 0; s < 64; ++s) {
                const int row = rowc + (dir ? 63 - s : s);
                const unsigned la = LA[(size_t)row * (DM / 2) + cp], uu = U[(size_t)row * (DM / 2) + cp];
                const float l0 = bf_lo(la), l1 = bf_hi(la);
                s0 += l0; s1 += l1;
                h0 = expf_(l0) * h0 + bf_lo(uu); h1 = expf_(l1) * h1 + bf_hi(uu);
            }
            const size_t o = ((size_t)(dir * 4 + b) * 68 + p) * DM + 2 * cp;
            *(f32x2*)(CA + o) = (f32x2){s0, s1}; *(f32x2*)(CB + o) = (f32x2){h0, h1};
        }
    }
    grid.sync();
    if (PH(10))
    { IDS();
    for (int idx = gt; idx < 2 * 4 * 1024; idx += NGT) {
        const int cp = idx & 1023, db = idx >> 10;
        float h0 = 0.f, h1 = 0.f;
        for (int p = 0; p < 68; ++p) {
            const size_t o = ((size_t)db * 68 + p) * DM + 2 * cp;
            *(f32x2*)(SS + o) = (f32x2){h0, h1};
            const f32x2 a = *(const f32x2*)(CA + o), bb = *(const f32x2*)(CB + o);
            h0 = expf_(a.x) * h0 + bb.x; h1 = expf_(a.y) * h1 + bb.y;
        }
    }
    }
    grid.sync();
    if (PH(11))
    { IDS();
        LAS unsigned* hfb = (LAS unsigned*)L;
        for (int it = bx; it < 4 * 64 * 2; it += G) {
            const int half = it & 1, q = it >> 1, c = q & 63, b = q >> 6;
            const int cp = half * 512 + tid;
            const int row0 = b * SEQ + c * 64;
            {
                const f32x2 st = *(const f32x2*)(SS + ((size_t)(0 * 4 + b) * 68 + (c + 4)) * DM + 2 * cp);
                float h0 = st.x, h1 = st.y;
                const unsigned* LA = (const unsigned*)LAf; const unsigned* U = (const unsigned*)Uf;
#pragma unroll 8
                for (int s = 0; s < 64; ++s) {
                    const size_t o = (size_t)(row0 + s) * (DM / 2) + cp;
                    const unsigned la = LA[o], uu = U[o];
                    h0 = expf_(bf_lo(la)) * h0 + bf_lo(uu); h1 = expf_(bf_hi(la)) * h1 + bf_hi(uu);
                    hfb[s * 512 + tid] = cvt_pk_bf16(h0, h1);
                }
            }
            {
                const f32x2 st = *(const f32x2*)(SS + ((size_t)(1 * 4 + b) * 68 + (67 - c)) * DM + 2 * cp);
                float h0 = st.x, h1 = st.y;
                const unsigned* LA = (const unsigned*)LAb; const unsigned* U = (const unsigned*)Ub;
                const unsigned* LGp = (const unsigned*)LGb; const unsigned* GLp = (const unsigned*)GLb; unsigned* AG = (unsigned*)Qb;
#pragma unroll 8
                for (int s = 63; s >= 0; --s) {
                    const size_t o = (size_t)(row0 + s) * (DM / 2) + cp;
                    const unsigned la = LA[o], uu = U[o], lg = LGp[o], gl = GLp[o], ag = AG[o];
                    h0 = expf_(bf_lo(la)) * h0 + bf_lo(uu); h1 = expf_(bf_hi(la)) * h1 + bf_hi(uu);
                    const unsigned hf = hfb[s * 512 + tid];
                    const float r0 = bf_lo(ag) + sigmoidf_(bf_lo(gl)) * (bf_lo(hf) + h0) * gelu_tanh(bf_lo(lg));
                    const float r1 = bf_hi(ag) + sigmoidf_(bf_hi(gl)) * (bf_hi(hf) + h1) * gelu_tanh(bf_hi(lg));
                    AG[o] = cvt_pk_bf16(r0, r1);
                }
            }
        }
        __syncthreads();
    }
    grid.sync();
    if (PH(12))
    { IDS();
        pg8::Gemm g{Qb, Wout_t, DM, DM, DM}; pg8::StaticOrder S; S.init(MLAT, DM, G, bx);
        pg8::EpiResid E{outp, outp, outp, outp, MOD + 5 * DM, 1.0f};
        pg8::gemm_phase<pg8::EpiResid, pg8::StaticOrder>(L, g, S, E);
    }
    grid.sync();
    if (PH(13))
    { IDS();
    norm_mod_rows(outp, outp, MLAT, norm_g + 2 * DM, MOD, 6, H, gw, NGW, lane);
    convert_ffn(ffn_wg + (size_t)DM * DFF, ffn_wu + (size_t)DM * DFF, ffn_wd + (size_t)DM * DFF, Wgu_t, Wd_t, scr, gw, NGW, lane);
    }
    grid.sync();
    if (PH(14))
    { IDS();
        pg8::Gemm g{H, Wgu_t, DM, DM, DM}; pg8::StaticOrder S; S.init(MLAT, NGU, G, bx);
        pg8::EpiSwiGLU E{ACT, DFF};
        pg8::gemm_phase<pg8::EpiSwiGLU, pg8::StaticOrder>(L, g, S, E);
    }
    grid.sync();
    if (PH(15))
    { IDS();
        pg8::Gemm g{ACT, Wd_t, DFF, DFF, DFF}; pg8::StaticOrder S; S.init(MLAT, DM, G, bx);
        pg8::EpiResid E{outp, outp, outp, outp, MOD + 8 * DM, 0.5f};
        pg8::gemm_phase<pg8::EpiResid, pg8::StaticOrder>(L, g, S, E);
    }
    grid.sync();
    if (PH(16))
    { IDS();
    for (int m = gw; m < MLAT; m += NGW) {
        f32x4* xr = (f32x4*)(outp + (size_t)m * DM);
        f32x4 v[8]; float s = 0.f;
#pragma unroll
        for (int j = 0; j < 8; ++j) { v[j] = xr[lane + 64 * j]; s += v[j].x * v[j].x + v[j].y * v[j].y + v[j].z * v[j].z + v[j].w * v[j].w; }
        const float rstd = 1.0f / sqrtf(wave_sum(s) * (1.0f / DM) + EPS);
#pragma unroll
        for (int j = 0; j < 8; ++j) xr[lane + 64 * j] = v[j] * rstd * ((const f32x4*)final_g)[lane + 64 * j];
    }
    }
}

extern "C" void kernel_launch(void* const* d_in, const int* in_sizes, int n_in, void* d_out, int out_size, void* d_ws, size_t ws_size, hipStream_t stream) {
    static int grid = 0;
    if (grid == 0) {
        int dev = 0, cus = 0, per_cu = 0;
        (void)hipGetDevice(&dev);
        (void)hipDeviceGetAttribute(&cus, hipDeviceAttributeMultiprocessorCount, dev);
        if (hipFuncSetAttribute((const void*)mk_fwd, hipFuncAttributeMaxDynamicSharedMemorySize, LDS_BYTES) != hipSuccess) fprintf(stderr, "hipFuncSetAttribute failed\n");
        (void)hipOccupancyMaxActiveBlocksPerMultiprocessor(&per_cu, (const void*)mk_fwd, NTHR, LDS_BYTES);
        grid = cus;
        if (ws_size < WS_END || n_in != 22) { fprintf(stderr, "kernel_launch: ws_size %zu < %zu or n_in %d != 22\n", ws_size, (size_t)WS_END, n_in); grid = -1; }
        fprintf(stderr, "grid %d (per_cu %d) ws_size %zu\n", grid, per_cu, ws_size);
    }
    if (grid < 0) return;
    Args a{};
    for (int i = 0; i < 22; ++i) a.in[i] = (const float*)d_in[i];
    a.out = (float*)d_out; a.ws = (unsigned char*)d_ws;
    void* params[] = {&a};
    hipError_t e = hipLaunchCooperativeKernel((const void*)mk_fwd, dim3(grid), dim3(NTHR), params, LDS_BYTES, stream);
    if (e != hipSuccess) fprintf(stderr, "cooperative launch failed: %s\n", hipGetErrorString(e));
}
```

```cpp
#include <hip/hip_runtime.h>
#include <hip/hip_cooperative_groups.h>
#include <cstdio>
#include <cstdint>
namespace cg = cooperative_groups;

#define LAS __attribute__((address_space(3)))
typedef unsigned short bf16_t;
typedef short bf16x8 __attribute__((ext_vector_type(8)));
typedef short s16x4 __attribute__((ext_vector_type(4)));
typedef float f32x4 __attribute__((ext_vector_type(4)));
typedef float f32x2 __attribute__((ext_vector_type(2)));
typedef float f32x16 __attribute__((ext_vector_type(16)));
typedef unsigned u32x4 __attribute__((ext_vector_type(4)));
typedef unsigned u32x2 __attribute__((ext_vector_type(2)));

constexpr int NWAVES = 8, NTHR = 512;
constexpr int LDS_BYTES = 147456;
constexpr int DM = 2048, MLAT = 16384, MCTX = 1024, MALL = 17408, SEQ = 4096, CTXL = 256;
constexpr int DFF = 5632, NGU = 11264, INW = 11264, NMODC = 18432;
constexpr int KVW = 512, SKV = 4352;
constexpr float EPS = 1e-6f;
constexpr size_t MiB = 1u << 20;
constexpr size_t WS_MOD = 0;
constexpr size_t WS_BAR = 512 * 1024;
constexpr size_t WS_MODP = 1 * MiB;
constexpr size_t WS_CA = 13 * MiB, WS_CB = 18 * MiB, WS_SS = 23 * MiB;
constexpr size_t WS_XC1 = 28 * MiB;
constexpr size_t WS_WOUT = 36 * MiB;
constexpr size_t WS_WLRU = 44 * MiB;
constexpr size_t WS_W1X = 46 * MiB;
constexpr size_t WS_WGU = WS_W1X, WS_WD = WS_W1X + 44 * MiB, WS_WIN = WS_W1X + 66 * MiB;
constexpr size_t WS_LAB = WS_W1X, WS_UB = WS_W1X + 68 * MiB;
constexpr size_t WS_H = 182 * MiB;
constexpr size_t WS_ARENA = 250 * MiB;
constexpr size_t WS_ACT = WS_ARENA;
constexpr size_t WS_Q = WS_ARENA, WS_GA = WS_ARENA + 64 * MiB, WS_K = WS_ARENA + 128 * MiB, WS_V = WS_ARENA + 145 * MiB,
                 WS_LX = WS_ARENA + 162 * MiB, WS_LG = WS_ARENA + 230 * MiB, WS_GL = WS_ARENA + 294 * MiB;
constexpr size_t WS_LAF = WS_GA, WS_UF = WS_LX;
constexpr size_t WS_END = WS_ARENA + 358 * MiB;

__device__ __forceinline__ unsigned cvt_pk_bf16(float lo, float hi) { unsigned r; asm volatile("v_cvt_pk_bf16_f32 %0, %1, %2" : "=v"(r) : "v"(lo), "v"(hi)); return r; }
__device__ __forceinline__ float bf_lo(unsigned w) { return __uint_as_float(w << 16); }
__device__ __forceinline__ float bf_hi(unsigned w) { return __uint_as_float(w & 0xffff0000u); }
__device__ __forceinline__ float bf2f(bf16_t h) { return __uint_as_float(((unsigned)h) << 16); }
__device__ __forceinline__ bf16_t f2bf(float f) { unsigned u = __float_as_uint(f); return (bf16_t)((u + 0x7fffu + ((u >> 16) & 1u)) >> 16); }
__device__ __forceinline__ float sigmoidf_(float v) { return __builtin_amdgcn_rcpf(1.0f + __builtin_amdgcn_exp2f(-1.4426950408889634f * v)); }
__device__ __forceinline__ float siluf_(float v) { return v * sigmoidf_(v); }
__device__ __forceinline__ float gelu_tanh(float v) { const float z = 0.7978845608028654f * (v + 0.044715f * v * v * v); return v * sigmoidf_(2.0f * z); }
__device__ __forceinline__ float expf_(float v) { return __builtin_amdgcn_exp2f(1.4426950408889634f * v); }
__device__ __forceinline__ float wave_sum(float v) {
#pragma unroll
    for (int o = 1; o < 64; o <<= 1) v += __shfl_xor(v, o);
    return v;
}
__device__ __forceinline__ void unpack8(const u32x4 w, float (&x)[8]) {
    x[0] = bf_lo(w.x); x[1] = bf_hi(w.x); x[2] = bf_lo(w.y); x[3] = bf_hi(w.y); x[4] = bf_lo(w.z); x[5] = bf_hi(w.z); x[6] = bf_lo(w.w); x[7] = bf_hi(w.w);
}
__device__ __forceinline__ u32x4 pack8(const float (&x)[8]) {
    u32x4 w; w.x = cvt_pk_bf16(x[0], x[1]); w.y = cvt_pk_bf16(x[2], x[3]); w.z = cvt_pk_bf16(x[4], x[5]); w.w = cvt_pk_bf16(x[6], x[7]); return w;
}

namespace pg8 {
constexpr int BM = 256, BK = 64, HALF = 128, HTB = HALF * BK * 2, STAGE_BYTES = 8 * HTB, NXCD = 8, WGM = 8;
__device__ __forceinline__ int lds_byte(int r, int c) { const int st = (r >> 4) * 2 + (c >> 5), rr = r & 15, cc = c & 31, ob = rr * 64 + cc * 2; return st * 1024 + (ob ^ (((ob >> 9) & 1) << 5)); }
__device__ __forceinline__ void stage_rc(int b, int& R, int& C) { const int st = b / 1024, sb = b % 1024, swz = sb ^ (((sb >> 9) & 1) << 5); R = (st >> 1) * 16 + swz / 64; C = (st & 1) * 32 + (swz % 64) / 2; }
__device__ __forceinline__ int perm32(int rho) { const int n = rho >> 4, i = rho & 15; return 8 * (i >> 2) + 4 * n + (i & 3); }

struct Unit { int pm, pn, ka; };
struct Gemm { const bf16_t* A; const bf16_t* Bt; int lda, ldb, K; };

struct StaticOrder {
    int nM, nN, nwg, G, c;
    __device__ void init(int M, int N, int G_, int c_) { nM = M / BM; nN = N / BM; nwg = nM * nN; G = G_; c = c_; }
    __device__ bool next(int i, Unit& u) const {
        const long L = (long)i * G + c; if (L >= nwg) return false;
        int wgid = (int)L; { const int q = nwg / NXCD, r = nwg % NXCD, xcd = wgid % NXCD, off = wgid / NXCD; wgid = (xcd < r ? xcd * (q + 1) : r * (q + 1) + (xcd - r) * q) + off; }
        const int nig = WGM * nN, gid = wgid / nig, fm = gid * WGM, gsz = (nM - fm) < WGM ? (nM - fm) : WGM;
        u.pm = fm + ((wgid % nig) % gsz); u.pn = (wgid % nig) / gsz; u.ka = 0; return true;
    }
};
struct LruOrder {
    int G, c;
    __device__ bool next(int i, Unit& u) const {
        const int L = i * G + c; if (L >= 68 * 32) return false;
        u.pn = L & 31; u.pm = L >> 5; u.ka = (u.pn >> 1) * 128; return true;
    }
};

template <class Epi, class Sched>
__device__ __forceinline__ void gemm_phase(LAS unsigned char* lds, const Gemm g, const Sched& S, const Epi& E) {
    int tid = threadIdx.x; asm volatile("" : "+v"(tid));
    const int wid = __builtin_amdgcn_readfirstlane(tid >> 6), lane = tid & 63, wr = wid >> 2, wc = wid & 3, fr = lane & 15, fq = lane >> 4;
    const int nt = g.K / BK;
    unsigned voffA[2], voffB[2];
#pragma unroll
    for (int i = 0; i < 2; ++i) { int R, C; stage_rc(tid * 16 + i * 8192, R, C); const int Rb = Epi::PERM ? ((R & ~31) + perm32(R & 31)) : R;
        voffA[i] = (unsigned)(R * g.lda + C) * 2u; voffB[i] = (unsigned)(Rb * g.ldb + C) * 2u; }
    const size_t kstep = (size_t)(BK * 2);
    const size_t hA = (size_t)HALF * g.lda * 2, hB = (size_t)HALF * g.ldb * 2;
    const unsigned ldsw = (unsigned)wid * 1024u;
    const int aoff = lds_byte(wr * 64 + fr, fq * 8), boff = lds_byte(wc * 32 + fr, fq * 8);
#define PG8_SA(b, h) (((b) * 2 + (h)) * HTB)
#define PG8_SB(b, h) ((4 + (b) * 2 + (h)) * HTB)
#define PG8_STAGE(bufoff, gbase, voff) do { _Pragma("unroll") for (int _i = 0; _i < 2; ++_i) \
        __builtin_amdgcn_global_load_lds((const unsigned*)((const char*)(gbase) + (voff)[_i]), (LAS unsigned*)(lds + (bufoff) + ldsw + _i * 8192), 16, 0, 0); } while (0)
#define PG8_LDA(dst, b, h) do { _Pragma("unroll") for (int m = 0; m < 4; ++m) _Pragma("unroll") for (int k = 0; k < 2; ++k) dst[m][k] = *(const LAS bf16x8*)(lds + PG8_SA(b, h) + aoff + m * 2048 + k * 1024); } while (0)
#define PG8_LDB(dst, b, h) do { _Pragma("unroll") for (int n = 0; n < 2; ++n) _Pragma("unroll") for (int k = 0; k < 2; ++k) dst[n][k] = *(const LAS bf16x8*)(lds + PG8_SB(b, h) + boff + n * 2048 + k * 1024); } while (0)
#define PG8_MMA(ai, bj, At, Bt) do { __builtin_amdgcn_s_setprio(1); _Pragma("unroll") for (int m = 0; m < 4; ++m) _Pragma("unroll") for (int n = 0; n < 2; ++n) _Pragma("unroll") for (int k = 0; k < 2; ++k) \
        acc[ai][bj][m][n] = __builtin_amdgcn_mfma_f32_16x16x32_bf16(Bt[n][k], At[m][k], acc[ai][bj][m][n], 0, 0, 0); __builtin_amdgcn_s_setprio(0); } while (0)
#define PG8_WAIT_V(n) asm volatile("s_waitcnt vmcnt(" #n ")" ::: "memory")
#define PG8_WAIT_L(n) asm volatile("s_waitcnt lgkmcnt(" #n ")" ::: "memory")
#define PG8_BAR __builtin_amdgcn_s_barrier()
#define PG8_SCHED __builtin_amdgcn_sched_barrier(0)
    Unit cur, nxt; int ui = 0;
    if (!S.next(0, cur)) return;
    f32x4 acc[2][2][4][2];
#pragma unroll
    for (int a = 0; a < 2; ++a)
#pragma unroll
        for (int b = 0; b < 2; ++b)
#pragma unroll
            for (int m = 0; m < 4; ++m)
#pragma unroll
                for (int n = 0; n < 2; ++n) acc[a][b][m][n] = (f32x4){0.f, 0.f, 0.f, 0.f};
    bf16x8 At[4][2], B0[2][2], B1[2][2];
    const char* cA = (const char*)g.A + (size_t)cur.pm * 2 * hA + (size_t)cur.ka * 2; const char* cB = (const char*)g.Bt + (size_t)cur.pn * 2 * hB;
    PG8_STAGE(PG8_SB(0, 0), cB, voffB); PG8_STAGE(PG8_SB(0, 1), cB + hB, voffB); PG8_STAGE(PG8_SA(0, 0), cA, voffA); PG8_STAGE(PG8_SA(0, 1), cA + hA, voffA);
    if (wr == 1) PG8_BAR;
    PG8_WAIT_V(2); PG8_BAR;
    PG8_STAGE(PG8_SB(1, 0), cB + kstep, voffB); PG8_STAGE(PG8_SA(1, 0), cA + kstep, voffA); PG8_STAGE(PG8_SB(1, 1), cB + hB + kstep, voffB);
    PG8_WAIT_V(6); PG8_BAR;
    for (;;) {
        const bool has_next = S.next(ui + 1, nxt);
        const char* nA = has_next ? (const char*)g.A + (size_t)nxt.pm * 2 * hA + (size_t)nxt.ka * 2 : cA; const char* nB = has_next ? (const char*)g.Bt + (size_t)nxt.pn * 2 * hB : cB;
        for (int t = 0; t < nt; t += 2) {
            const bool last = (t == nt - 2);
            const char* a1 = cA + (size_t)(t + 1) * kstep;
            const char* a2 = last ? nA : cA + (size_t)(t + 2) * kstep; const char* b2 = last ? nB : cB + (size_t)(t + 2) * kstep;
            const char* a3 = a2 + kstep; const char* b3 = b2 + kstep;
            PG8_LDB(B0, 0, 0); PG8_LDB(B1, 0, 1); PG8_SCHED; PG8_LDA(At, 0, 0); PG8_STAGE(PG8_SA(1, 1), a1 + hA, voffA);
            PG8_WAIT_V(8); PG8_WAIT_L(0); PG8_BAR; PG8_MMA(0, 0, At, B0); PG8_MMA(0, 1, At, B1); PG8_BAR; PG8_SCHED;
            PG8_LDA(At, 0, 1); PG8_STAGE(PG8_SB(0, 0), b2, voffB); PG8_STAGE(PG8_SB(0, 1), b2 + hB, voffB); PG8_STAGE(PG8_SA(0, 0), a2, voffA);
            PG8_WAIT_V(8); PG8_WAIT_L(0); PG8_BAR; PG8_MMA(1, 0, At, B0); PG8_MMA(1, 1, At, B1); PG8_BAR; PG8_SCHED;
            PG8_LDB(B0, 1, 0); PG8_LDB(B1, 1, 1); PG8_SCHED; PG8_LDA(At, 1, 0); PG8_STAGE(PG8_SA(0, 1), a2 + hA, voffA);
            PG8_WAIT_V(8); PG8_WAIT_L(0); PG8_BAR; PG8_MMA(0, 0, At, B0); PG8_MMA(0, 1, At, B1); PG8_BAR; PG8_SCHED;
            PG8_LDA(At, 1, 1); PG8_STAGE(PG8_SB(1, 0), b3, voffB); PG8_STAGE(PG8_SB(1, 1), b3 + hB, voffB); PG8_STAGE(PG8_SA(1, 0), a3, voffA);
            PG8_WAIT_V(8); PG8_WAIT_L(0); PG8_BAR; PG8_MMA(1, 0, At, B0); PG8_MMA(1, 1, At, B1); PG8_BAR; PG8_SCHED;
        }
        if (wr == 0) PG8_BAR;
        E(acc, cur, wr, wc, fr, fq);
        if (!has_next) break;
#pragma unroll
        for (int a = 0; a < 2; ++a)
#pragma unroll
            for (int b = 0; b < 2; ++b)
#pragma unroll
                for (int m = 0; m < 4; ++m)
#pragma unroll
                    for (int n = 0; n < 2; ++n) acc[a][b][m][n] = (f32x4){0.f, 0.f, 0.f, 0.f};
        cur = nxt; cA = nA; cB = nB; ++ui;
        if (wr == 1) PG8_BAR;
    }
    PG8_WAIT_V(0);
    PG8_BAR;
#undef PG8_SA
#undef PG8_SB
#undef PG8_STAGE
#undef PG8_LDA
#undef PG8_LDB
#undef PG8_MMA
#undef PG8_WAIT_V
#undef PG8_WAIT_L
#undef PG8_BAR
#undef PG8_SCHED
}

struct EpiSwiGLU {
    static constexpr bool PERM = true;
    bf16_t* O; int ldc;
    __device__ __forceinline__ void operator()(const f32x4 (&acc)[2][2][4][2], const Unit& u, int wr, int wc, int fr, int fq) const {
        const int row0 = u.pm * BM + wr * 64 + fr, col0 = u.pn * HALF + wc * 32 + 8 * fq;
#pragma unroll
        for (int ai = 0; ai < 2; ++ai)
#pragma unroll
            for (int m = 0; m < 4; ++m) {
                bf16_t* rowp = O + (size_t)(row0 + ai * HALF + m * 16) * ldc + col0;
                const f32x4 g0 = acc[ai][0][m][0], g1 = acc[ai][0][m][1], u0 = acc[ai][1][m][0], u1 = acc[ai][1][m][1];
                u32x4 w;
                w.x = cvt_pk_bf16(siluf_(g0[0]) * u0[0], siluf_(g0[1]) * u0[1]); w.y = cvt_pk_bf16(siluf_(g0[2]) * u0[2], siluf_(g0[3]) * u0[3]);
                w.z = cvt_pk_bf16(siluf_(g1[0]) * u1[0], siluf_(g1[1]) * u1[1]); w.w = cvt_pk_bf16(siluf_(g1[2]) * u1[2], siluf_(g1[3]) * u1[3]);
                *(u32x4*)rowp = w;
            }
    }
};
struct EpiResid {
    static constexpr bool PERM = false;
    const float* base_lat; const float* base_ctx; float* out_lat; float* out_ctx; const float* gate; float s;
    __device__ __forceinline__ void operator()(const f32x4 (&acc)[2][2][4][2], const Unit& u, int wr, int wc, int fr, int fq) const {
        const bool lat = u.pm < 64;
        const float* base = lat ? base_lat + (size_t)u.pm * BM * DM : base_ctx + (size_t)(u.pm - 64) * BM * DM;
        float* out = lat ? out_lat + (size_t)u.pm * BM * DM : out_ctx + (size_t)(u.pm - 64) * BM * DM;
        const float* grow = gate + (size_t)(lat ? (u.pm >> 4) : 4) * NMODC;
        const int col0 = u.pn * BM + wc * 32 + 4 * fq;
#pragma unroll
        for (int bj = 0; bj < 2; ++bj)
#pragma unroll
            for (int n = 0; n < 2; ++n) {
                const int col = col0 + bj * HALF + n * 16;
                const f32x4 gv = *(const f32x4*)(grow + col) * s;
#pragma unroll
                for (int ai = 0; ai < 2; ++ai)
#pragma unroll
                    for (int m = 0; m < 4; ++m) {
                        const size_t off = (size_t)(ai * HALF + wr * 64 + m * 16 + fr) * DM + col;
                        const f32x4 bs = *(const f32x4*)(base + off);
                        *(f32x4*)(out + off) = bs + gv * acc[ai][bj][m][n];
                    }
            }
    }
};
struct EpiInProj {
    static constexpr bool PERM = true;
    bf16_t *Q, *K, *V, *LX, *LG, *GA, *GL;
    __device__ __forceinline__ void operator()(const f32x4 (&acc)[2][2][4][2], const Unit& u, int wr, int wc, int fr, int fq) const {
        const int pn = u.pn, pm = u.pm;
        bf16_t* base; int ld, ct; bool all_rows = false, kv = false;
        if (pn < 8) { base = Q; ld = DM; ct = pn; }
        else if (pn < 10) { base = K; ld = KVW; ct = pn - 8; kv = true; all_rows = true; }
        else if (pn < 12) { base = V; ld = KVW; ct = pn - 10; kv = true; all_rows = true; }
        else if (pn < 20) { base = LX; ld = DM; ct = pn - 12; all_rows = true; }
        else if (pn < 28) { base = LG; ld = DM; ct = pn - 20; }
        else if (pn < 36) { base = GA; ld = DM; ct = pn - 28; }
        else { base = GL; ld = DM; ct = pn - 36; }
        if (!all_rows && pm >= 64) return;
        int rowbase = pm * BM;
        if (kv) rowbase = pm < 64 ? (pm >> 4) * SKV + CTXL + (pm & 15) * BM : (pm - 64) * SKV;
        const int row0 = rowbase + wr * 64 + fr, col0 = ct * BM + wc * 32 + 8 * fq;
#pragma unroll
        for (int ai = 0; ai < 2; ++ai)
#pragma unroll
            for (int m = 0; m < 4; ++m) {
                bf16_t* rowp = base + (size_t)(row0 + ai * HALF + m * 16) * ld + col0;
#pragma unroll
                for (int bj = 0; bj < 2; ++bj) {
                    const f32x4 v0 = acc[ai][bj][m][0], v1 = acc[ai][bj][m][1];
                    u32x4 w; w.x = cvt_pk_bf16(v0[0], v0[1]); w.y = cvt_pk_bf16(v0[2], v0[3]); w.z = cvt_pk_bf16(v1[0], v1[1]); w.w = cvt_pk_bf16(v1[2], v1[3]);
                    *(u32x4*)(rowp + bj * HALF) = w;
                }
            }
    }
};
struct EpiLru {
    static constexpr bool PERM = true;
    const bf16_t* XC; bf16_t *LAf, *Uf, *LAb, *Ub; const float *ba, *bx, *lam;
    __device__ __forceinline__ void operator()(const f32x4 (&acc)[2][2][4][2], const Unit& u, int wr, int wc, int fr, int fq) const {
        const int nb = u.pn >> 1, dir = u.pn & 1;
        const int ch0 = nb * 128 + wc * 32 + 8 * fq;
        bf16_t* LA = dir ? LAb : LAf; bf16_t* U = dir ? Ub : Uf;
        float cba[8], cbx[8], csp[8];
#pragma unroll
        for (int e = 0; e < 8; ++e) { cba[e] = ba[dir * DM + ch0 + e]; cbx[e] = bx[dir * DM + ch0 + e];
            const float l = lam[dir * DM + ch0 + e]; csp[e] = -8.0f * __logf(1.0f + __expf(-l)); }
        const int row0 = u.pm * BM + wr * 64 + fr;
#pragma unroll
        for (int ai = 0; ai < 2; ++ai)
#pragma unroll
            for (int m = 0; m < 4; ++m) {
                const size_t off = (size_t)(row0 + ai * HALF + m * 16) * DM + ch0;
                float xv[8]; unpack8(*(const u32x4*)(XC + off), xv);
                float la[8], uu[8];
#pragma unroll
                for (int e = 0; e < 8; ++e) {
                    const float za = acc[ai][0][m][e >> 2][e & 3] + cba[e], zx = acc[ai][1][m][e >> 2][e & 3] + cbx[e];
                    const float r = sigmoidf_(za), ig = sigmoidf_(zx);
                    const float l = csp[e] * r;
                    const float y = 2.0f * l;
                    const float em = (y > -0.02f) ? -y * (1.0f + 0.5f * y * (1.0f + 0.33333333f * y)) : 1.0f - expf_(y);
                    la[e] = l; uu[e] = __builtin_sqrtf(em) * ig * xv[e];
                }
                *(u32x4*)(LA + off) = pack8(la); *(u32x4*)(U + off) = pack8(uu);
            }
    }
};
}

namespace att {
#ifndef ATT_SDEPTH
#define ATT_SDEPTH 2
#endif
constexpr int D = 128, NW = 8, QBLK = 32, KVBLK = 64;
constexpr float SCALE = 0.088388347648318440f;
constexpr float THR = 8.f;
constexpr int LDQ = DM, LDK = KVW, LDO = DM;
constexpr size_t SHM_V = KVBLK * D * 2, SHM_K = KVBLK * D * 2, SHM_ATTN = 2 * SHM_V + 2 * SHM_K + NW * 64 * 4;
#define KSWZ(row, colB) ((row) * 256 + ((colB) ^ (((row) & 7) << 4)))
#define SBAR() __builtin_amdgcn_sched_barrier(0)
__device__ __forceinline__ int crow(int r, int hi) { return (r & 3) + 8 * (r >> 2) + 4 * hi; }
__device__ __forceinline__ void partialSM(f32x16& p0, f32x16& p1, float& m_reg, float& mn, float& alpha) {
  constexpr float C = SCALE * 1.4426950408889634f;
  float pmax = p0[0]; for (int r = 1; r < 16; ++r) pmax = fmaxf(pmax, p0[r]); for (int r = 0; r < 16; ++r) pmax = fmaxf(pmax, p1[r]);
  { auto rr = __builtin_amdgcn_permlane32_swap(__float_as_uint(pmax), __float_as_uint(pmax), false, false);
    pmax = fmaxf(__uint_as_float(rr[0]), __uint_as_float(rr[1])); }
  if (__builtin_expect(__all(pmax - m_reg <= THR / SCALE), 1)) { mn = m_reg; alpha = 1.f; }
  else { mn = fmaxf(m_reg, pmax); alpha = __builtin_amdgcn_exp2f((m_reg - mn) * C); m_reg = mn; }
  float mnC = -mn * C;
  for (int r = 0; r < 16; ++r) p0[r] = fmaf(p0[r], C, mnC); for (int r = 0; r < 16; ++r) p1[r] = fmaf(p1[r], C, mnC);
  for (int r = 0; r < 16; ++r) p0[r] = __builtin_amdgcn_exp2f(p0[r]);
}
__device__ __forceinline__ void finishSM(f32x16& p0, f32x16& p1, float alpha, float& l_reg, bf16x8& pa0, bf16x8& pa1, bf16x8& pa2, bf16x8& pa3) {
  for (int r = 0; r < 16; ++r) p1[r] = __builtin_amdgcn_exp2f(p1[r]);
  float ps = 0; for (int r = 0; r < 16; ++r) ps += p0[r]; for (int r = 0; r < 16; ++r) ps += p1[r];
  { auto rr = __builtin_amdgcn_permlane32_swap(__float_as_uint(ps), __float_as_uint(ps), false, false);
    ps = __uint_as_float(rr[0]) + __uint_as_float(rr[1]); }
  l_reg = l_reg * alpha + ps;
#define PK4(P, BASE, OUT) do { unsigned a0 = cvt_pk_bf16(P[BASE + 0], P[BASE + 1]), a1 = cvt_pk_bf16(P[BASE + 2], P[BASE + 3]);   \
    unsigned b0 = cvt_pk_bf16(P[BASE + 4], P[BASE + 5]), b1 = cvt_pk_bf16(P[BASE + 6], P[BASE + 7]);                              \
    auto r0 = __builtin_amdgcn_permlane32_swap(a0, b0, false, false); auto r1 = __builtin_amdgcn_permlane32_swap(a1, b1, false, false); \
    u32x4 w = {r0[0], r1[0], r0[1], r1[1]}; OUT = *reinterpret_cast<bf16x8*>(&w); } while (0)
  PK4(p0, 0, pa0); PK4(p0, 8, pa1); PK4(p1, 0, pa2); PK4(p1, 8, pa3);
#undef PK4
}
__device__ __forceinline__ void qkt(f32x16& p0, f32x16& p1, const bf16_t* Ks, const bf16x8* qr, int r32, int hi) {
  p0 = f32x16{}; p1 = f32x16{};
  for (int d0 = 0; d0 < 8; ++d0) { int cb = (d0 * 16 + hi * 8) * 2;
    bf16x8 b0 = *reinterpret_cast<const bf16x8*>((const char*)Ks + KSWZ(r32, cb));
    bf16x8 b1 = *reinterpret_cast<const bf16x8*>((const char*)Ks + KSWZ(32 + r32, cb));
    p0 = __builtin_amdgcn_mfma_f32_32x32x16_bf16(b0, qr[d0], p0, 0, 0, 0);
    p1 = __builtin_amdgcn_mfma_f32_32x32x16_bf16(b1, qr[d0], p1, 0, 0, 0); }
}
__device__ __forceinline__ int v_st(int k, int c) { const int kk = (k & ~0xC) | ((k & 4) << 1) | ((k & 8) >> 1); return ((kk >> 3) * 4 + (c >> 5)) * 512 + ((kk & 7) * 32 + (c & 31)) * 2; }
__device__ __forceinline__ int v_rd_base(int lane) { return ((lane & 3) << 3) | (((lane >> 2) & 3) << 6) | (((lane >> 4) & 1) << 5) | (((lane >> 5) & 1) << 8); }
constexpr int v_rd_off(int d0, int ks, int half) { return d0 * 512 + ks * 4096 + half * 2048; }
template <int OFF> __device__ __forceinline__ s16x4 tr_read(int vb) {
  s16x4 r; asm volatile("ds_read_b64_tr_b16 %0, %1 offset:%2" : "=&v"(r) : "v"(vb), "i"(OFF) : "memory"); return r;
}
template <int D0> __device__ __forceinline__ void pv_one(f32x16& od, int vb, bf16x8 pa0, bf16x8 pa1, bf16x8 pa2, bf16x8 pa3) {
  const s16x4 l0 = tr_read<v_rd_off(D0, 0, 0)>(vb), h0 = tr_read<v_rd_off(D0, 0, 1)>(vb), l1 = tr_read<v_rd_off(D0, 1, 0)>(vb), h1 = tr_read<v_rd_off(D0, 1, 1)>(vb);
  const s16x4 l2 = tr_read<v_rd_off(D0, 2, 0)>(vb), h2 = tr_read<v_rd_off(D0, 2, 1)>(vb), l3 = tr_read<v_rd_off(D0, 3, 0)>(vb), h3 = tr_read<v_rd_off(D0, 3, 1)>(vb);
  asm volatile("s_waitcnt lgkmcnt(0)" ::: "memory"); SBAR();
#define PK(L, H) (bf16x8){L[0], L[1], L[2], L[3], H[0], H[1], H[2], H[3]}
  od = __builtin_amdgcn_mfma_f32_32x32x16_bf16(pa0, PK(l0, h0), od, 0, 0, 0);
  od = __builtin_amdgcn_mfma_f32_32x32x16_bf16(pa1, PK(l1, h1), od, 0, 0, 0);
  od = __builtin_amdgcn_mfma_f32_32x32x16_bf16(pa2, PK(l2, h2), od, 0, 0, 0);
  od = __builtin_amdgcn_mfma_f32_32x32x16_bf16(pa3, PK(l3, h3), od, 0, 0, 0);
#undef PK
}
__device__ __forceinline__ void pv_d0(f32x16* o, int vb, bf16x8 pa0, bf16x8 pa1, bf16x8 pa2, bf16x8 pa3) {
  pv_one<0>(o[0], vb, pa0, pa1, pa2, pa3); pv_one<1>(o[1], vb, pa0, pa1, pa2, pa3); pv_one<2>(o[2], vb, pa0, pa1, pa2, pa3); pv_one<3>(o[3], vb, pa0, pa1, pa2, pa3);
}
__device__ __forceinline__ void attn_dense_body(const bf16_t* Qb, const bf16_t* __restrict__ Kh, const bf16_t* __restrict__ Vh,
                                                bf16_t* Ob, const bf16_t* Gb, int seq, char* lds) {
  int tid = threadIdx.x; asm volatile("" : "+v"(tid));
  const int wid = tid >> 6, lane = tid & 63, r32 = lane & 31, hi = lane >> 5;
  bf16_t* V_lds = (bf16_t*)lds; bf16_t* K_lds = (bf16_t*)(lds + 2 * SHM_V);
  float* ws = (float*)(lds + 2 * SHM_V + 2 * SHM_K) + wid * 64; float* li_l = ws; float* al_l = ws + 32;
  float m_reg = -1e30f, l_reg = 0; f32x16 o[4] = {}; bf16x8 qr[8];
  const bf16_t* Qw = Qb + (long)(wid * QBLK + r32) * LDQ + hi * 8;
#pragma unroll
  for (int d0 = 0; d0 < 8; ++d0) qr[d0] = *reinterpret_cast<const bf16x8*>(Qw + d0 * 16);
  const int sr = tid >> 4, sc = (tid & 15) * 8, vst0 = v_st(sr, sc), vst1 = v_st(32 + sr, sc);
  const int vb0 = (int)(uintptr_t)V_lds + v_rd_base(lane);
  constexpr int SDEPTH = ATT_SDEPTH;
  struct { bf16x8 vs0, vs1, ks0, ks1; } sr_[SDEPTH];
#define LD8(p) (*reinterpret_cast<const bf16x8*>(p))
#define SLOAD(i, k0) do { sr_[i].vs0 = LD8(&Vh[(long)((k0) + sr) * LDK + sc]); sr_[i].vs1 = LD8(&Vh[(long)((k0) + 32 + sr) * LDK + sc]); \
    sr_[i].ks0 = LD8(&Kh[(long)((k0) + sr) * LDK + sc]); sr_[i].ks1 = LD8(&Kh[(long)((k0) + 32 + sr) * LDK + sc]); } while (0)
#define SWRITE(b, i) do { *(bf16x8*)((char*)V_lds + (b) * SHM_V + vst0) = sr_[i].vs0;          \
    *(bf16x8*)((char*)V_lds + (b) * SHM_V + vst1) = sr_[i].vs1; int kc = sc * 2;               \
    *(bf16x8*)((char*)K_lds + (b) * SHM_K + KSWZ(sr, kc)) = sr_[i].ks0;                       \
    *(bf16x8*)((char*)K_lds + (b) * SHM_K + KSWZ(32 + sr, kc)) = sr_[i].ks1; } while (0)
#define SWAIT() do { if constexpr (SDEPTH == 2) asm volatile("s_waitcnt vmcnt(4)" ::: "memory"); else asm volatile("s_waitcnt vmcnt(0)" ::: "memory"); } while (0)
#define RESC(a) do { if (__any((a) < 1.f)) { if (hi == 0) al_l[r32] = (a); asm volatile("s_waitcnt lgkmcnt(0)" ::: "memory"); \
    for (int d = 0; d < 4; ++d) for (int r = 0; r < 16; ++r) o[d][r] *= al_l[crow(r, hi)]; } } while (0)
  f32x16 pA0, pA1, pB0, pB1; float mnA, mnB, alA, alB; bf16x8 pa0, pa1, pa2, pa3; const int NT = seq / KVBLK;
  constexpr int SE = 0, SO = SDEPTH - 1;
  SLOAD(SE, 0); asm volatile("s_waitcnt vmcnt(0)" ::: "memory"); SWRITE(0, SE); __syncthreads();
  qkt(pA0, pA1, K_lds, qr, r32, hi); partialSM(pA0, pA1, m_reg, mnA, alA);
  SLOAD(SO, KVBLK); if constexpr (SDEPTH == 2) { if (2 < NT) SLOAD(SE, 2 * KVBLK); }
  SWAIT(); SWRITE(1, SO); __syncthreads();
  for (int j = 1; j + 1 < NT; j += 2) {
    SBAR(); qkt(pB0, pB1, (bf16_t*)((char*)K_lds + SHM_K), qr, r32, hi);
    finishSM(pA0, pA1, alA, l_reg, pa0, pa1, pa2, pa3); SBAR();
    SLOAD(SO, (j + SDEPTH) * KVBLK); SBAR();
    pv_d0(o, vb0, pa0, pa1, pa2, pa3); partialSM(pB0, pB1, m_reg, mnB, alB);
    __syncthreads(); SWAIT(); SWRITE(0, SE);
    RESC(alB); __syncthreads();
    SBAR(); qkt(pA0, pA1, K_lds, qr, r32, hi);
    finishSM(pB0, pB1, alB, l_reg, pa0, pa1, pa2, pa3); SBAR();
    if (SDEPTH == 1 || j + 3 < NT) SLOAD(SE, (j + 1 + SDEPTH) * KVBLK); SBAR();
    pv_d0(o, vb0 + (int)SHM_V, pa0, pa1, pa2, pa3); partialSM(pA0, pA1, m_reg, mnA, alA);
    __syncthreads(); SWAIT(); SWRITE(1, SO);
    RESC(alA); __syncthreads();
  }
  SBAR(); qkt(pB0, pB1, (bf16_t*)((char*)K_lds + SHM_K), qr, r32, hi);
  finishSM(pA0, pA1, alA, l_reg, pa0, pa1, pa2, pa3); SBAR();
  pv_d0(o, vb0, pa0, pa1, pa2, pa3); partialSM(pB0, pB1, m_reg, mnB, alB);
  __syncthreads(); RESC(alB);
  finishSM(pB0, pB1, alB, l_reg, pa0, pa1, pa2, pa3); SBAR();
  pv_d0(o, vb0 + (int)SHM_V, pa0, pa1, pa2, pa3);
  if (hi == 0) li_l[r32] = l_reg; asm volatile("s_waitcnt lgkmcnt(0)" ::: "memory");
  float rli[16];
#pragma unroll
  for (int r = 0; r < 16; ++r) rli[r] = __builtin_amdgcn_rcpf(li_l[crow(r, hi)]);
  bf16_t* Ow = Ob + (long)(wid * QBLK) * LDO; const bf16_t* Gw = Gb + (long)(wid * QBLK) * LDO;
#pragma unroll
  for (int r = 0; r < 16; ++r) { int orow = crow(r, hi);
#pragma unroll
    for (int d0 = 0; d0 < 4; ++d0) { const long idx = (long)orow * LDO + d0 * 32 + r32;
      Ow[idx] = f2bf(o[d0][r] * rli[r]); }
    asm volatile("" ::: "memory"); }
  asm volatile("s_waitcnt vmcnt(0)" ::: "memory");
#pragma unroll 2
  for (int r = 0; r < 16; ++r) { int orow = crow(r, hi);
#pragma unroll
    for (int d0 = 0; d0 < 4; ++d0) { const long idx = (long)orow * LDO + d0 * 32 + r32;
      Ow[idx] = f2bf(bf2f(Ow[idx]) * sigmoidf_(bf2f(Gw[idx]))); }
    asm volatile("" ::: "memory"); }
#undef LD8
#undef SLOAD
#undef SWRITE
#undef SWAIT
#undef RESC
}
}


#define XB_TMO      128
#define XB_XCNT(j)  (256  + 64 * (j))
#define XB_XSUB(j)  (1280 + 64 * (j))
#define XB_XGEN(j)  (2304 + 64 * (j))
#define XB_TOP      3328
#define XB_TOPGEN   3392
#define XCD_BAR_WORDS 3456
#define XB_SPIN_CAP (1u << 18)
__device__ __forceinline__ unsigned xb_ld(unsigned* p)              { return __hip_atomic_load(p, __ATOMIC_RELAXED, __HIP_MEMORY_SCOPE_AGENT); }
__device__ __forceinline__ unsigned xb_add(unsigned* p, unsigned v) { return __hip_atomic_fetch_add(p, v, __ATOMIC_RELAXED, __HIP_MEMORY_SCOPE_AGENT); }
__device__ __forceinline__ unsigned xb_xcc_id() { return (unsigned)__builtin_amdgcn_s_getreg((3 << 11) | 20) & 0xFu; }
#define XB_SPIN(cond, bar) do { unsigned _sp = 0; while (cond) { __builtin_amdgcn_s_sleep(1); \
    if ((++_sp & 255u) == 0u) { if (xb_ld(&(bar)[XB_TMO])) break; if (_sp > XB_SPIN_CAP) { atomicAdd(&(bar)[XB_TMO], 1u); break; } } } } while (0)
struct XcdBarrier { unsigned* bar; unsigned x; volatile LAS unsigned* st; };
__device__ __forceinline__ XcdBarrier xcd_barrier_post(unsigned* bar, volatile LAS unsigned* st) {
    XcdBarrier b; b.bar = bar; b.x = xb_xcc_id(); b.st = st;
    if (threadIdx.x == 0) (void)xb_add(&bar[XB_XCNT(b.x)], 1u);
    return b;
}
__device__ __forceinline__ void xcd_barrier_complete(unsigned* bar, unsigned x, unsigned& nloc, unsigned& nx) {
    const unsigned G = gridDim.x * gridDim.y * gridDim.z;
    unsigned sum, cnt, mine, sp = 0u;
    for (;;) {
        sum = 0u; cnt = 0u; mine = 0u;
#pragma unroll
        for (unsigned j = 0; j < 16; ++j) { const unsigned c = xb_ld(&bar[XB_XCNT(j)]); sum += c; cnt += (c > 0u) ? 1u : 0u; mine = (j == x) ? c : mine; }
        if (sum == G) break;
        __builtin_amdgcn_s_sleep(1);
        if ((++sp & 255u) == 0u) { if (xb_ld(&bar[XB_TMO])) break; if (sp > XB_SPIN_CAP) { atomicAdd(&bar[XB_TMO], 1u); break; } }
    }
    nloc = mine > 0u ? mine : 1u; nx = cnt > 0u ? cnt : 1u;
}
__device__ __forceinline__ void xcd_barrier(const XcdBarrier& b) {
    asm volatile("s_waitcnt vmcnt(0)" ::: "memory");
    __syncthreads();
    if (threadIdx.x == 0) {
        unsigned* bar = b.bar;
        __builtin_amdgcn_s_waitcnt(0);
        unsigned nloc = b.st[0], nx = b.st[1];
        if (nloc == 0u) { xcd_barrier_complete(bar, b.x, nloc, nx); b.st[0] = nloc; b.st[1] = nx; }
        const unsigned old = xb_add(&bar[XB_XSUB(b.x)], 1u);
        const unsigned gen = old / nloc;
        if (old + 1u == (gen + 1u) * nloc) {
            __builtin_amdgcn_fence(__ATOMIC_RELEASE, "agent");
            asm volatile("s_waitcnt vmcnt(0)" ::: "memory");
            const unsigned og = xb_add(&bar[XB_TOP], 1u);
            const unsigned tg = og / nx;
            if (og + 1u == (tg + 1u) * nx) xb_add(&bar[XB_TOPGEN], 1u);
            else XB_SPIN(xb_ld(&bar[XB_TOPGEN]) == tg, bar);
            __builtin_amdgcn_fence(__ATOMIC_ACQUIRE, "agent");
            xb_add(&bar[XB_XGEN(b.x)], 1u);
            asm volatile("s_waitcnt vmcnt(0)" ::: "memory");
        } else {
            XB_SPIN(xb_ld(&bar[XB_XGEN(b.x)]) == gen, bar);
            __builtin_amdgcn_fence(__ATOMIC_ACQUIRE, "agent");
            asm volatile("s_waitcnt vmcnt(0)" ::: "memory");
        }
    }
    __syncthreads();
}

__device__ __forceinline__ void transpose_item(const float* W, int ldw, int k0, int n0, bf16_t* WT, int ldt, int drow0, LAS float* scr, int lane) {
#pragma unroll 8
    for (int i = 0; i < 32; ++i) { const int kk = 2 * i + (lane >> 5); scr[kk * 33 + (lane & 31)] = W[(size_t)(k0 + kk) * ldw + n0 + (lane & 31)]; }
    asm volatile("s_waitcnt lgkmcnt(0)" ::: "memory");
    const int c = lane & 7;
#pragma unroll
    for (int j = 0; j < 4; ++j) { const int n = (lane >> 3) + 8 * j; const LAS float* s = scr + (8 * c) * 33 + n;
        u32x4 o; o.x = cvt_pk_bf16(s[0 * 33], s[1 * 33]); o.y = cvt_pk_bf16(s[2 * 33], s[3 * 33]); o.z = cvt_pk_bf16(s[4 * 33], s[5 * 33]); o.w = cvt_pk_bf16(s[6 * 33], s[7 * 33]);
        *(u32x4*)(WT + (size_t)(drow0 + n) * ldt + k0 + 8 * c) = o; }
    asm volatile("s_waitcnt lgkmcnt(0)" ::: "memory");
}
__device__ __forceinline__ void convert_ffn(const float* wg, const float* wu, const float* wd, bf16_t* Wgu, bf16_t* Wd, LAS float* scr, int gw, int NGW, int lane) {
    constexpr int I_G = 32 * 176, I_D = 88 * 64;
    for (int it = gw; it < 2 * I_G + I_D; it += NGW) {
        if (it < 2 * I_G) { const int which = it >= I_G, r = which ? it - I_G : it; const int kb = r / 176, nb = r % 176, n0 = nb * 32;
            transpose_item(which ? wu : wg, DFF, kb * 64, n0, Wgu, DM, (n0 >> 7) * 256 + (n0 & 127) + which * 128, scr, lane); }
        else { const int r = it - 2 * I_G; const int kb = r / 64, nb = r % 64;
            transpose_item(wd, DM, kb * 64, nb * 32, Wd, DFF, nb * 32, scr, lane); }
    }
}

__device__ __forceinline__ void norm_mod_rows(const float* xlat, const float* xctx, int nrows, const float* g, const float* mod, int shi, bf16_t* H, int gw, int NGW, int lane) {
    for (int m = gw; m < nrows; m += NGW) {
        const bool lat = m < MLAT;
        const float* xr = lat ? xlat + (size_t)m * DM : xctx + (size_t)(m - MLAT) * DM;
        const float* mr = mod + (size_t)(lat ? (m >> 12) : 4) * NMODC + shi * DM;
        f32x4 v[8]; float s = 0.f;
#pragma unroll
        for (int j = 0; j < 8; ++j) { v[j] = ((const f32x4*)xr)[lane + 64 * j]; s += v[j].x * v[j].x + v[j].y * v[j].y + v[j].z * v[j].z + v[j].w * v[j].w; }
        const float rstd = 1.0f / sqrtf(wave_sum(s) * (1.0f / DM) + EPS);
#pragma unroll
        for (int j = 0; j < 8; ++j) {
            const int c4 = lane + 64 * j;
            const f32x4 gg = ((const f32x4*)g)[c4], sh = ((const f32x4*)mr)[c4], sc = ((const f32x4*)(mr + DM))[c4];
            const f32x4 y = v[j] * rstd * gg * (sc + 1.0f) + sh;
            u32x2 w; w.x = cvt_pk_bf16(y.x, y.y); w.y = cvt_pk_bf16(y.z, y.w);
            ((u32x2*)(H + (size_t)m * DM))[c4] = w;
        }
    }
}

#ifndef PH_MASK
#define PH_MASK 0xFFFFFFFu
#endif
#define PH(n) (((PH_MASK) >> (n)) & 1u)
#ifndef REP_MASK
#define REP_MASK 0u
#endif
#ifndef SYNC_REP
#define SYNC_REP 1
#endif
#define NREP(n) (PH(n) ? 1 + (int)(((REP_MASK) >> (n)) & 1u) : 0)
struct Args { const float* in[22]; float* out; unsigned char* ws; };


typedef __attribute__((address_space(4))) const unsigned long long* kargp_t;
__device__ __forceinline__ unsigned long long kload(int i) {
    unsigned long long p = (unsigned long long)__builtin_amdgcn_kernarg_segment_ptr();
    asm volatile("" : "+s"(p));
    const unsigned long long v = ((kargp_t)p)[i];
    const unsigned lo = __builtin_amdgcn_readfirstlane((unsigned)v), hi = __builtin_amdgcn_readfirstlane((unsigned)(v >> 32));
    return ((unsigned long long)hi << 32) | lo;
}
#define GAS __attribute__((address_space(1)))
#define INP(i) ((const float*)(GAS const float*)kload(i))
#define wsb ((GAS unsigned char*)kload(23))
#define outp ((float*)(GAS float*)kload(22))
#define xin INP(0)
#define cvec INP(1)
#define ctx INP(2)
#define c_ctx INP(3)
#define w_mod INP(4)
#define b_mod INP(5)
#define norm_g INP(6)
#define ffn_wg INP(7)
#define ffn_wu INP(8)
#define ffn_wd INP(9)
#define w_in INP(10)
#define w_out INP(11)
#define q_norm_g INP(12)
#define k_norm_g INP(13)
#define conv_w INP(14)
#define conv_b INP(15)
#define lru_wa INP(16)
#define lru_ba INP(17)
#define lru_wx INP(18)
#define lru_bx INP(19)
#define lru_lambda INP(20)
#define final_g INP(21)
#define MOD ((float*)(GAS float*)(wsb + WS_MOD))
#define MODP ((float*)(GAS float*)(wsb + WS_MODP))
#define CA ((float*)(GAS float*)(wsb + WS_CA))
#define CB ((float*)(GAS float*)(wsb + WS_CB))
#define SS ((float*)(GAS float*)(wsb + WS_SS))
#define XC1 ((float*)(GAS float*)(wsb + WS_XC1))
#define Wout_t ((bf16_t*)(GAS bf16_t*)(wsb + WS_WOUT))
#define Wlru_t ((bf16_t*)(GAS bf16_t*)(wsb + WS_WLRU))
#define Wgu_t ((bf16_t*)(GAS bf16_t*)(wsb + WS_WGU))
#define Wd_t ((bf16_t*)(GAS bf16_t*)(wsb + WS_WD))
#define Win_t ((bf16_t*)(GAS bf16_t*)(wsb + WS_WIN))
#define H ((bf16_t*)(GAS bf16_t*)(wsb + WS_H))
#define ACT ((bf16_t*)(GAS bf16_t*)(wsb + WS_ACT))
#define Qb ((bf16_t*)(GAS bf16_t*)(wsb + WS_Q))
#define GAb ((bf16_t*)(GAS bf16_t*)(wsb + WS_GA))
#define Kb ((bf16_t*)(GAS bf16_t*)(wsb + WS_K))
#define Vb ((bf16_t*)(GAS bf16_t*)(wsb + WS_V))
#define LXb ((bf16_t*)(GAS bf16_t*)(wsb + WS_LX))
#define LGb ((bf16_t*)(GAS bf16_t*)(wsb + WS_LG))
#define GLb ((bf16_t*)(GAS bf16_t*)(wsb + WS_GL))
#define LAf ((bf16_t*)(GAS bf16_t*)(wsb + WS_LAF))
#define Uf ((bf16_t*)(GAS bf16_t*)(wsb + WS_UF))
#define LAb ((bf16_t*)(GAS bf16_t*)(wsb + WS_LAB))
#define Ub ((bf16_t*)(GAS bf16_t*)(wsb + WS_UB))

#define GSYNC() do { for (int sr_ = 0; sr_ < SYNC_REP; ++sr_) xcd_barrier(xbar); } while (0)
__global__ void __launch_bounds__(NTHR, 2) mk_fwd(Args args) {
    extern __shared__ __attribute__((aligned(16))) unsigned char lds[];
    cg::grid_group grid = cg::this_grid();
    LAS unsigned char* L = (LAS unsigned char*)lds;
    const int G = gridDim.x, bx = blockIdx.x;
    volatile LAS unsigned* xst = (volatile LAS unsigned*)(L + LDS_BYTES - 64);
    if (threadIdx.x < 2) xst[threadIdx.x] = 0u;
    if (bx == 0) { unsigned* bw = (unsigned*)(GAS unsigned*)(wsb + WS_BAR); for (int i = threadIdx.x; i < XCD_BAR_WORDS; i += NTHR) bw[i] = 0u; }
    XcdBarrier xbar;
#define IDS() int tid = threadIdx.x; asm volatile("" : "+v"(tid)); const int lane = tid & 63, wave = __builtin_amdgcn_readfirstlane(tid >> 6); \
    const int gw = bx * NWAVES + wave, NGW = G * NWAVES; const int gt = bx * NTHR + tid, NGT = G * NTHR; LAS float* scr = (LAS float*)(L + wave * 16384); \
    (void)lane; (void)gw; (void)NGW; (void)gt; (void)NGT; (void)scr;

    for (int rep_ = 0; rep_ < NREP(0); ++rep_)
    { if (rep_) xcd_barrier(xbar); IDS();
        for (int it = gw; it < 72 * 32; it += NGW) {
            const int jb = it % 72, kc = it / 72, j0 = jb * 256 + 4 * lane, k0 = kc * 64;
            float s[5];
#pragma unroll
            for (int r = 0; r < 5; ++r) { const float cv = r < 4 ? cvec[r * DM + k0 + lane] : c_ctx[k0 + lane]; s[r] = siluf_(cv); }
            f32x4 acc[5];
#pragma unroll
            for (int r = 0; r < 5; ++r) acc[r] = (f32x4){0.f, 0.f, 0.f, 0.f};
#pragma unroll 8
            for (int k = 0; k < 64; ++k) {
                const f32x4 w = *(const f32x4*)(w_mod + (size_t)(k0 + k) * NMODC + j0);
#pragma unroll
                for (int r = 0; r < 5; ++r) { const float sr = __uint_as_float(__builtin_amdgcn_readlane(__float_as_uint(s[r]), k)); acc[r] += w * sr; }
            }
#pragma unroll
            for (int r = 0; r < 5; ++r) *(f32x4*)(MODP + (size_t)(kc * 5 + r) * NMODC + j0) = acc[r];
        }
        convert_ffn(ffn_wg, ffn_wu, ffn_wd, Wgu_t, Wd_t, scr, gw, NGW, lane);
        constexpr int I_IN = 32 * 352, I_OUT = 32 * 64, I_LRU = 64 * 8;
        for (int it = gw; it < I_IN + I_OUT + I_LRU; it += NGW) {
            if (it < I_IN) { const int kb = it / 352, nb = it % 352; transpose_item(w_in, INW, kb * 64, nb * 32, Win_t, DM, nb * 32, scr, lane); }
            else if (it < I_IN + I_OUT) { const int r = it - I_IN, kb = r / 64, nb = r % 64; transpose_item(w_out, DM, kb * 64, nb * 32, Wout_t, DM, nb * 32, scr, lane); }
            else { const int r = it - I_IN - I_OUT, mat = r >> 3, sub = r & 7, kb = sub >> 2, nb4 = sub & 3;
                const int which = mat >> 5, dir = (mat >> 4) & 1, nb = mat & 15;
                const float* src = (which ? lru_wx : lru_wa) + (size_t)(dir * 16 + nb) * 128 * 128;
                transpose_item(src, 128, kb * 64, nb4 * 32, Wlru_t, 128, (nb * 2 + dir) * 256 + which * 128 + nb4 * 32, scr, lane); }
        }
    }
    grid.sync();
    xbar = xcd_barrier_post((unsigned*)(GAS unsigned*)(wsb + WS_BAR), xst);
    for (int rep_ = 0; rep_ < NREP(17); ++rep_)
    { if (rep_) xcd_barrier(xbar); IDS();
    for (int idx = gt; idx < 5 * (NMODC / 4); idx += NGT) {
        const int r = idx / (NMODC / 4), j4 = idx % (NMODC / 4);
        f32x4 sacc = ((const f32x4*)b_mod)[j4];
        for (int kc = 0; kc < 32; ++kc) sacc += ((const f32x4*)(MODP + (size_t)(kc * 5 + r) * NMODC))[j4];
        ((f32x4*)(MOD + (size_t)r * NMODC))[j4] = sacc;
    }
    }
    GSYNC();
    for (int rep_ = 0; rep_ < NREP(1); ++rep_)
    { if (rep_) xcd_barrier(xbar); IDS();
    norm_mod_rows(xin, ctx, MALL, norm_g, MOD, 0, H, gw, NGW, lane);
    }
    GSYNC();
    for (int rep_ = 0; rep_ < NREP(2); ++rep_)
    { if (rep_) xcd_barrier(xbar); IDS();
        pg8::Gemm g{H, Wgu_t, DM, DM, DM}; pg8::StaticOrder S; S.init(MALL, NGU, G, bx);
        pg8::EpiSwiGLU E{ACT, DFF};
        pg8::gemm_phase<pg8::EpiSwiGLU, pg8::StaticOrder>(L, g, S, E);
    }
    GSYNC();
    for (int rep_ = 0; rep_ < NREP(3); ++rep_)
    { if (rep_) xcd_barrier(xbar); IDS();
        pg8::Gemm g{ACT, Wd_t, DFF, DFF, DFF}; pg8::StaticOrder S; S.init(MALL, DM, G, bx);
        pg8::EpiResid E{xin, ctx, outp, XC1, MOD + 2 * DM, 0.5f};
        pg8::gemm_phase<pg8::EpiResid, pg8::StaticOrder>(L, g, S, E);
    }
    GSYNC();
    for (int rep_ = 0; rep_ < NREP(4); ++rep_)
    { if (rep_) xcd_barrier(xbar); IDS();
    norm_mod_rows(outp, XC1, MALL, norm_g + DM, MOD, 3, H, gw, NGW, lane);
    }
    GSYNC();
    for (int rep_ = 0; rep_ < NREP(5); ++rep_)
    { if (rep_) xcd_barrier(xbar); IDS();
        pg8::Gemm g{H, Win_t, DM, DM, DM}; pg8::StaticOrder S; S.init(MALL, INW, G, bx);
        pg8::EpiInProj E{Qb, Kb, Vb, LXb, LGb, GAb, GLb};
        pg8::gemm_phase<pg8::EpiInProj, pg8::StaticOrder>(L, g, S, E);
    }
    GSYNC();
    for (int rep_ = 0; rep_ < NREP(6); ++rep_)
    { if (rep_) xcd_barrier(xbar); IDS();
        bf16_t* XC = H;
        const int l16 = lane & 15;
        float gq[8], gk[8];
#pragma unroll
        for (int e = 0; e < 8; ++e) { gq[e] = q_norm_g[l16 * 8 + e]; gk[e] = k_norm_g[l16 * 8 + e]; }
        for (int m = gw; m < MALL; m += NGW) {
            const bool lat = m < MLAT;
            const int t = lat ? (m & (SEQ - 1)) : ((m - MLAT) & (CTXL - 1));
            const int b = lat ? (m >> 12) : ((m - MLAT) >> 8);
            float cs[4], sn[4];
#pragma unroll
            for (int p = 0; p < 4; ++p) { const int i = l16 * 4 + p; const int pos = (i < 32) ? (t >> 6) : (t & 63); const int j = i & 31;
                const float freq = __builtin_amdgcn_exp2f(-(float)j * (13.287712379549449f / 32.0f)); const float ang = (float)pos * freq;
                cs[p] = lat ? __cosf(ang) : 1.0f; sn[p] = lat ? __sinf(ang) : 0.0f; }
            const int kvrow = lat ? b * SKV + CTXL + t : b * SKV + t;
#pragma unroll
            for (int a = 0; a < 5; ++a) {
                if (a < 4 && !lat) continue;
                bf16_t* p = (a < 4) ? Qb + (size_t)m * DM + a * 512 + lane * 8 : Kb + (size_t)kvrow * KVW + lane * 8;
                float xv[8]; unpack8(*(const u32x4*)p, xv);
                float ss = 0.f;
#pragma unroll
                for (int e = 0; e < 8; ++e) ss += xv[e] * xv[e];
                ss += __shfl_xor(ss, 1); ss += __shfl_xor(ss, 2); ss += __shfl_xor(ss, 4); ss += __shfl_xor(ss, 8);
                const float rs = 1.0f / sqrtf(ss * (1.0f / 128.0f) + EPS);
                float y[8];
#pragma unroll
                for (int e = 0; e < 8; ++e) y[e] = xv[e] * rs * (a < 4 ? gq[e] : gk[e]);
#pragma unroll
                for (int pp = 0; pp < 4; ++pp) { const float y0 = y[2 * pp], y1 = y[2 * pp + 1]; y[2 * pp] = y0 * cs[pp] - y1 * sn[pp]; y[2 * pp + 1] = y0 * sn[pp] + y1 * cs[pp]; }
                *(u32x4*)p = pack8(y);
            }
            const int len = lat ? SEQ : CTXL;
#pragma unroll
            for (int a = 0; a < 4; ++a) {
                const int col = a * 512 + lane * 8;
                float acc[8];
#pragma unroll
                for (int e = 0; e < 8; ++e) acc[e] = conv_b[col + e];
#pragma unroll
                for (int d = 0; d < 4; ++d) {
                    const int tt = t + d - 2;
                    if (tt >= 0 && tt < len) {
                        float xv[8]; unpack8(*(const u32x4*)(LXb + (size_t)(m + d - 2) * DM + col), xv);
#pragma unroll
                        for (int e = 0; e < 8; ++e) acc[e] += xv[e] * conv_w[d * DM + col + e];
                    }
                }
                *(u32x4*)(XC + (size_t)m * DM + col) = pack8(acc);
            }
        }
    }
    GSYNC();
    for (int rep_ = 0; rep_ < NREP(7); ++rep_)
    { if (rep_) xcd_barrier(xbar); IDS();
        bf16_t* const q_ = Qb; const bf16_t* const k_ = Kb; const bf16_t* const v_ = Vb; const bf16_t* const g_ = GAb;
#pragma unroll 1
        for (int i = 0; i < 4; ++i) {
            const int xcd = bx & 7, cu = bx >> 3;
            const int pair = xcd * 2 + (i >> 1), idx = (i & 1) * 32 + cu;
            if (G != 256) break;
            const int b = pair >> 2, kvh = pair & 3, qh = kvh * 4 + (idx >> 4), qb = idx & 15;
            const size_t qoff = ((size_t)b * SEQ + qb * 256) * DM + qh * 128;
            const size_t koff = (size_t)b * SKV * KVW + kvh * 128;
            att::attn_dense_body(q_ + qoff, k_ + koff, v_ + koff, ((NREP(7) == 2 && rep_ == 0) ? (bf16_t*)LXb : q_) + qoff, g_ + qoff, SKV, (char*)lds);
            __syncthreads();
        }
    }
    GSYNC();
    for (int rep_ = 0; rep_ < NREP(8); ++rep_)
    { if (rep_) xcd_barrier(xbar); IDS();
        pg8::Gemm g{H, Wlru_t, DM, 128, 128}; pg8::LruOrder S{G, bx};
        pg8::EpiLru E{H, LAf, Uf, LAb, Ub, lru_ba, lru_bx, lru_lambda};
        pg8::gemm_phase<pg8::EpiLru, pg8::LruOrder>(L, g, S, E);
    }
    GSYNC();
    for (int rep_ = 0; rep_ < NREP(9); ++rep_)
    { if (rep_) xcd_barrier(xbar); IDS();
        for (int it = bx; it < 2 * 4 * 68 * 2; it += G) {
            const int half = it & 1, q = it >> 1, p = q % 68, db = q / 68, b = db & 3, dir = db >> 2;
            const int cp = half * 512 + tid;
            int rowc;
            if (dir == 0) rowc = (p < 4) ? MLAT + b * CTXL + p * 64 : b * SEQ + (p - 4) * 64;
            else rowc = (p < 4) ? MLAT + b * CTXL + (3 - p) * 64 : b * SEQ + (67 - p) * 64;
            const unsigned* LA = (const unsigned*)(dir ? LAb : LAf); const unsigned* U = (const unsigned*)(dir ? Ub : Uf);
            float s0 = 0.f, s1 = 0.f, h0 = 0.f, h1 = 0.f;
#pragma unroll 8
            for (int s = 0; s < 64; ++s) {
                const int row = rowc + (dir ? 63 - s : s);
                const unsigned la = LA[(size_t)row * (DM / 2) + cp], uu = U[(size_t)row * (DM / 2) + cp];
                const float l0 = bf_lo(la), l1 = bf_hi(la);
                s0 += l0; s1 += l1;
                h0 = expf_(l0) * h0 + bf_lo(uu); h1 = expf_(l1) * h1 + bf_hi(uu);
            }
            const size_t o = ((size_t)(dir * 4 + b) * 68 + p) * DM + 2 * cp;
            *(f32x2*)(CA + o) = (f32x2){s0, s1}; *(f32x2*)(CB + o) = (f32x2){h0, h1};
        }
    }
    GSYNC();
    for (int rep_ = 0; rep_ < NREP(10); ++rep_)
    { if (rep_) xcd_barrier(xbar); IDS();
    for (int idx = gt; idx < 2 * 4 * 1024; idx += NGT) {
        const int cp = idx & 1023, db = idx >> 10;
        float h0 = 0.f, h1 = 0.f;
        const float* ca_ = CA; const float* cb_ = CB; float* ss_ = SS;
#pragma unroll 1
        for (int p0 = 0; p0 < 68; p0 += 17) {
            f32x2 a[17], bb[17];
#pragma unroll
            for (int q = 0; q < 17; ++q) { const size_t o = ((size_t)db * 68 + p0 + q) * DM + 2 * cp; a[q] = *(const f32x2*)(ca_ + o); bb[q] = *(const f32x2*)(cb_ + o); }
#pragma unroll
            for (int q = 0; q < 17; ++q) { const size_t o = ((size_t)db * 68 + p0 + q) * DM + 2 * cp;
                *(f32x2*)(ss_ + o) = (f32x2){h0, h1};
                h0 = expf_(a[q].x) * h0 + bb[q].x; h1 = expf_(a[q].y) * h1 + bb[q].y; }
        }
    }
    }
    GSYNC();
    for (int rep_ = 0; rep_ < NREP(11); ++rep_)
    { if (rep_) xcd_barrier(xbar); IDS();
        LAS unsigned* hfb = (LAS unsigned*)L;
        for (int it = bx; it < 4 * 64 * 2; it += G) {
            const int half = it & 1, q = it >> 1, c = q & 63, b = q >> 6;
            const int cp = half * 512 + tid;
            const int row0 = b * SEQ + c * 64;
            {
                const f32x2 st = *(const f32x2*)(SS + ((size_t)(0 * 4 + b) * 68 + (c + 4)) * DM + 2 * cp);
                float h0 = st.x, h1 = st.y;
                const unsigned* LA = (const unsigned*)LAf; const unsigned* U = (const unsigned*)Uf;
#pragma unroll 8
                for (int s = 0; s < 64; ++s) {
                    const size_t o = (size_t)(row0 + s) * (DM / 2) + cp;
                    const unsigned la = LA[o], uu = U[o];
                    h0 = expf_(bf_lo(la)) * h0 + bf_lo(uu); h1 = expf_(bf_hi(la)) * h1 + bf_hi(uu);
                    hfb[s * 512 + tid] = cvt_pk_bf16(h0, h1);
                }
            }
            {
                const f32x2 st = *(const f32x2*)(SS + ((size_t)(1 * 4 + b) * 68 + (67 - c)) * DM + 2 * cp);
                float h0 = st.x, h1 = st.y;
                const unsigned* LA = (const unsigned*)LAb; const unsigned* U = (const unsigned*)Ub;
                const unsigned* LGp = (const unsigned*)LGb; const unsigned* GLp = (const unsigned*)GLb; unsigned* AG = (unsigned*)Qb;
#pragma unroll 8
                for (int s = 63; s >= 0; --s) {
                    const size_t o = (size_t)(row0 + s) * (DM / 2) + cp;
                    const unsigned la = LA[o], uu = U[o], lg = LGp[o], gl = GLp[o], ag = AG[o];
                    h0 = expf_(bf_lo(la)) * h0 + bf_lo(uu); h1 = expf_(bf_hi(la)) * h1 + bf_hi(uu);
                    const unsigned hf = hfb[s * 512 + tid];
                    const float r0 = bf_lo(ag) + sigmoidf_(bf_lo(gl)) * (bf_lo(hf) + h0) * gelu_tanh(bf_lo(lg));
                    const float r1 = bf_hi(ag) + sigmoidf_(bf_hi(gl)) * (bf_hi(hf) + h1) * gelu_tanh(bf_hi(lg));
                    AG[o] = cvt_pk_bf16(r0, r1);
                }
            }
        }
        __syncthreads();
    }
    GSYNC();
    for (int rep_ = 0; rep_ < NREP(12); ++rep_)
    { if (rep_) xcd_barrier(xbar); IDS();
        pg8::Gemm g{Qb, Wout_t, DM, DM, DM}; pg8::StaticOrder S; S.init(MLAT, DM, G, bx);
        pg8::EpiResid E{outp, outp, outp, outp, MOD + 5 * DM, 1.0f};
        pg8::gemm_phase<pg8::EpiResid, pg8::StaticOrder>(L, g, S, E);
    }
    GSYNC();
    for (int rep_ = 0; rep_ < NREP(13); ++rep_)
    { if (rep_) xcd_barrier(xbar); IDS();
    norm_mod_rows(outp, outp, MLAT, norm_g + 2 * DM, MOD, 6, H, gw, NGW, lane);
    convert_ffn(ffn_wg + (size_t)DM * DFF, ffn_wu + (size_t)DM * DFF, ffn_wd + (size_t)DM * DFF, Wgu_t, Wd_t, scr, gw, NGW, lane);
    }
    GSYNC();
    for (int rep_ = 0; rep_ < NREP(14); ++rep_)
    { if (rep_) xcd_barrier(xbar); IDS();
        pg8::Gemm g{H, Wgu_t, DM, DM, DM}; pg8::StaticOrder S; S.init(MLAT, NGU, G, bx);
        pg8::EpiSwiGLU E{ACT, DFF};
        pg8::gemm_phase<pg8::EpiSwiGLU, pg8::StaticOrder>(L, g, S, E);
    }
    GSYNC();
    for (int rep_ = 0; rep_ < NREP(15); ++rep_)
    { if (rep_) xcd_barrier(xbar); IDS();
        pg8::Gemm g{ACT, Wd_t, DFF, DFF, DFF}; pg8::StaticOrder S; S.init(MLAT, DM, G, bx);
        pg8::EpiResid E{outp, outp, outp, outp, MOD + 8 * DM, 0.5f};
        pg8::gemm_phase<pg8::EpiResid, pg8::StaticOrder>(L, g, S, E);
    }
    GSYNC();
    for (int rep_ = 0; rep_ < NREP(16); ++rep_)
    { if (rep_) xcd_barrier(xbar); IDS();
    for (int m = gw; m < MLAT; m += NGW) {
        f32x4* xr = (f32x4*)(outp + (size_t)m * DM);
        f32x4 v[8]; float s = 0.f;
#pragma unroll
        for (int j = 0; j < 8; ++j) { v[j] = xr[lane + 64 * j]; s += v[j].x * v[j].x + v[j].y * v[j].y + v[j].z * v[j].z + v[j].w * v[j].w; }
        const float rstd = 1.0f / sqrtf(wave_sum(s) * (1.0f / DM) + EPS);
#pragma unroll
        for (int j = 0; j < 8; ++j) xr[lane + 64 * j] = v[j] * rstd * ((const f32x4*)final_g)[lane + 64 * j];
    }
    }
}

extern "C" void kernel_launch(void* const* d_in, const int* in_sizes, int n_in, void* d_out, int out_size, void* d_ws, size_t ws_size, hipStream_t stream) {
    static int grid = 0;
    if (grid == 0) {
        int dev = 0, cus = 0, per_cu = 0;
        (void)hipGetDevice(&dev);
        (void)hipDeviceGetAttribute(&cus, hipDeviceAttributeMultiprocessorCount, dev);
        if (hipFuncSetAttribute((const void*)mk_fwd, hipFuncAttributeMaxDynamicSharedMemorySize, LDS_BYTES) != hipSuccess) fprintf(stderr, "hipFuncSetAttribute failed\n");
        (void)hipOccupancyMaxActiveBlocksPerMultiprocessor(&per_cu, (const void*)mk_fwd, NTHR, LDS_BYTES);
        grid = cus;
        if (ws_size < WS_END || n_in != 22) { fprintf(stderr, "kernel_launch: ws_size %zu < %zu or n_in %d != 22\n", ws_size, (size_t)WS_END, n_in); grid = -1; }
        fprintf(stderr, "grid %d (per_cu %d) ws_size %zu\n", grid, per_cu, ws_size);
    }
    if (grid < 0) return;
    Args a{};
    for (int i = 0; i < 22; ++i) a.in[i] = (const float*)d_in[i];
    a.out = (float*)d_out; a.ws = (unsigned char*)d_ws;
    void* params[] = {&a};
    hipError_t e = hipLaunchCooperativeKernel((const void*)mk_fwd, dim3(grid), dim3(NTHR), params, LDS_BYTES, stream);
    if (e != hipSuccess) fprintf(stderr, "cooperative launch failed: %s\n", hipGetErrorString(e));
}
```

```cpp
#include <hip/hip_runtime.h>
#include <hip/hip_cooperative_groups.h>
#include <cstdio>
#include <cstdint>
namespace cg = cooperative_groups;

#define LAS __attribute__((address_space(3)))
typedef unsigned short bf16_t;
typedef short bf16x8 __attribute__((ext_vector_type(8)));
typedef short s16x4 __attribute__((ext_vector_type(4)));
typedef float f32x4 __attribute__((ext_vector_type(4)));
typedef float f32x2 __attribute__((ext_vector_type(2)));
typedef float f32x16 __attribute__((ext_vector_type(16)));
typedef unsigned u32x4 __attribute__((ext_vector_type(4)));
typedef unsigned u32x2 __attribute__((ext_vector_type(2)));

constexpr int NWAVES = 8, NTHR = 512;
constexpr int LDS_BYTES = 147456;
constexpr int DM = 2048, MLAT = 16384, MCTX = 1024, MALL = 17408, SEQ = 4096, CTXL = 256;
constexpr int DFF = 5632, NGU = 11264, INW = 11264, NMODC = 18432;
constexpr int KVW = 512, SKV = 4352;
constexpr float EPS = 1e-6f;
constexpr size_t MiB = 1u << 20;
constexpr size_t WS_MOD = 0;
constexpr size_t WS_BAR = 512 * 1024;
constexpr size_t WS_MODP = 1 * MiB;
constexpr size_t WS_CA = 13 * MiB, WS_CB = 18 * MiB, WS_SS = 23 * MiB;
constexpr size_t WS_XC1 = 28 * MiB;
constexpr size_t WS_WOUT = 36 * MiB;
constexpr size_t WS_WLRU = 44 * MiB;
constexpr size_t WS_W1X = 46 * MiB;
constexpr size_t WS_WGU = WS_W1X, WS_WD = WS_W1X + 44 * MiB, WS_WIN = WS_W1X + 66 * MiB;
constexpr size_t WS_LAB = WS_W1X, WS_UB = WS_W1X + 68 * MiB;
constexpr size_t WS_H = 182 * MiB;
constexpr size_t WS_ARENA = 250 * MiB;
constexpr size_t WS_ACT = WS_ARENA;
constexpr size_t WS_Q = WS_ARENA, WS_GA = WS_ARENA + 64 * MiB, WS_K = WS_ARENA + 128 * MiB, WS_V = WS_ARENA + 145 * MiB,
                 WS_LX = WS_ARENA + 162 * MiB, WS_LG = WS_ARENA + 230 * MiB, WS_GL = WS_ARENA + 294 * MiB;
constexpr size_t WS_LAF = WS_GA, WS_UF = WS_LX;
constexpr size_t WS_END = WS_ARENA + 358 * MiB;

__device__ __forceinline__ unsigned cvt_pk_bf16(float lo, float hi) { unsigned r; asm volatile("v_cvt_pk_bf16_f32 %0, %1, %2" : "=v"(r) : "v"(lo), "v"(hi)); return r; }
__device__ __forceinline__ float bf_lo(unsigned w) { return __uint_as_float(w << 16); }
__device__ __forceinline__ float bf_hi(unsigned w) { return __uint_as_float(w & 0xffff0000u); }
__device__ __forceinline__ float bf2f(bf16_t h) { return __uint_as_float(((unsigned)h) << 16); }
__device__ __forceinline__ bf16_t f2bf(float f) { unsigned u = __float_as_uint(f); return (bf16_t)((u + 0x7fffu + ((u >> 16) & 1u)) >> 16); }
__device__ __forceinline__ float sigmoidf_(float v) { return __builtin_amdgcn_rcpf(1.0f + __builtin_amdgcn_exp2f(-1.4426950408889634f * v)); }
__device__ __forceinline__ float siluf_(float v) { return v * sigmoidf_(v); }
__device__ __forceinline__ float gelu_tanh(float v) { const float z = 0.7978845608028654f * (v + 0.044715f * v * v * v); return v * sigmoidf_(2.0f * z); }
__device__ __forceinline__ float expf_(float v) { return __builtin_amdgcn_exp2f(1.4426950408889634f * v); }
__device__ __forceinline__ float wave_sum(float v) {
#pragma unroll
    for (int o = 1; o < 64; o <<= 1) v += __shfl_xor(v, o);
    return v;
}
__device__ __forceinline__ void unpack8(const u32x4 w, float (&x)[8]) {
    x[0] = bf_lo(w.x); x[1] = bf_hi(w.x); x[2] = bf_lo(w.y); x[3] = bf_hi(w.y); x[4] = bf_lo(w.z); x[5] = bf_hi(w.z); x[6] = bf_lo(w.w); x[7] = bf_hi(w.w);
}
__device__ __forceinline__ u32x4 pack8(const float (&x)[8]) {
    u32x4 w; w.x = cvt_pk_bf16(x[0], x[1]); w.y = cvt_pk_bf16(x[2], x[3]); w.z = cvt_pk_bf16(x[4], x[5]); w.w = cvt_pk_bf16(x[6], x[7]); return w;
}

namespace pg8 {
constexpr int BM = 256, BK = 64, HALF = 128, HTB = HALF * BK * 2, STAGE_BYTES = 8 * HTB, NXCD = 8, WGM = 8;
__device__ __forceinline__ int lds_byte(int r, int c) { const int st = (r >> 4) * 2 + (c >> 5), rr = r & 15, cc = c & 31, ob = rr * 64 + cc * 2; return st * 1024 + (ob ^ (((ob >> 9) & 1) << 5)); }
__device__ __forceinline__ void stage_rc(int b, int& R, int& C) { const int st = b / 1024, sb = b % 1024, swz = sb ^ (((sb >> 9) & 1) << 5); R = (st >> 1) * 16 + swz / 64; C = (st & 1) * 32 + (swz % 64) / 2; }
__device__ __forceinline__ int perm32(int rho) { const int n = rho >> 4, i = rho & 15; return 8 * (i >> 2) + 4 * n + (i & 3); }

struct Unit { int pm, pn, ka; };
struct Gemm { const bf16_t* A; const bf16_t* Bt; int lda, ldb, K; };

struct StaticOrder {
    int nM, nN, nwg, G, c;
    __device__ void init(int M, int N, int G_, int c_) { nM = M / BM; nN = N / BM; nwg = nM * nN; G = G_; c = c_; }
    __device__ bool next(int i, Unit& u) const {
        const long L = (long)i * G + c; if (L >= nwg) return false;
        int wgid = (int)L; { const int q = nwg / NXCD, r = nwg % NXCD, xcd = wgid % NXCD, off = wgid / NXCD; wgid = (xcd < r ? xcd * (q + 1) : r * (q + 1) + (xcd - r) * q) + off; }
        const int nig = WGM * nN, gid = wgid / nig, fm = gid * WGM, gsz = (nM - fm) < WGM ? (nM - fm) : WGM;
        u.pm = fm + ((wgid % nig) % gsz); u.pn = (wgid % nig) / gsz; u.ka = 0; return true;
    }
};
struct LruOrder {
    int G, c;
    __device__ bool next(int i, Unit& u) const {
        const int L = i * G + c; if (L >= 68 * 32) return false;
        u.pn = L & 31; u.pm = L >> 5; u.ka = (u.pn >> 1) * 128; return true;
    }
};

template <class Epi, class Sched>
__device__ __forceinline__ void gemm_phase(LAS unsigned char* lds, const Gemm g, const Sched& S, const Epi& E) {
    int tid = threadIdx.x; asm volatile("" : "+v"(tid));
    const int wid = __builtin_amdgcn_readfirstlane(tid >> 6), lane = tid & 63, wr = wid >> 2, wc = wid & 3, fr = lane & 15, fq = lane >> 4;
    const int nt = g.K / BK;
    unsigned voffA[2], voffB[2];
#pragma unroll
    for (int i = 0; i < 2; ++i) { int R, C; stage_rc(tid * 16 + i * 8192, R, C); const int Rb = Epi::PERM ? ((R & ~31) + perm32(R & 31)) : R;
        voffA[i] = (unsigned)(R * g.lda + C) * 2u; voffB[i] = (unsigned)(Rb * g.ldb + C) * 2u; }
    const size_t kstep = (size_t)(BK * 2);
    const size_t hA = (size_t)HALF * g.lda * 2, hB = (size_t)HALF * g.ldb * 2;
    const unsigned ldsw = (unsigned)wid * 1024u;
    const int aoff = lds_byte(wr * 64 + fr, fq * 8), boff = lds_byte(wc * 32 + fr, fq * 8);
#define PG8_SA(b, h) (((b) * 2 + (h)) * HTB)
#define PG8_SB(b, h) ((4 + (b) * 2 + (h)) * HTB)
#define PG8_STAGE(bufoff, gbase, voff) do { _Pragma("unroll") for (int _i = 0; _i < 2; ++_i) \
        __builtin_amdgcn_global_load_lds((const unsigned*)((const char*)(gbase) + (voff)[_i]), (LAS unsigned*)(lds + (bufoff) + ldsw + _i * 8192), 16, 0, 0); } while (0)
#define PG8_LDA(dst, b, h) do { _Pragma("unroll") for (int m = 0; m < 4; ++m) _Pragma("unroll") for (int k = 0; k < 2; ++k) dst[m][k] = *(const LAS bf16x8*)(lds + PG8_SA(b, h) + aoff + m * 2048 + k * 1024); } while (0)
#define PG8_LDB(dst, b, h) do { _Pragma("unroll") for (int n = 0; n < 2; ++n) _Pragma("unroll") for (int k = 0; k < 2; ++k) dst[n][k] = *(const LAS bf16x8*)(lds + PG8_SB(b, h) + boff + n * 2048 + k * 1024); } while (0)
#define PG8_MMA(ai, bj, At, Bt) do { __builtin_amdgcn_s_setprio(1); _Pragma("unroll") for (int m = 0; m < 4; ++m) _Pragma("unroll") for (int n = 0; n < 2; ++n) _Pragma("unroll") for (int k = 0; k < 2; ++k) \
        acc[ai][bj][m][n] = __builtin_amdgcn_mfma_f32_16x16x32_bf16(Bt[n][k], At[m][k], acc[ai][bj][m][n], 0, 0, 0); __builtin_amdgcn_s_setprio(0); } while (0)
#define PG8_WAIT_V(n) asm volatile("s_waitcnt vmcnt(" #n ")" ::: "memory")
#define PG8_WAIT_L(n) asm volatile("s_waitcnt lgkmcnt(" #n ")" ::: "memory")
#define PG8_BAR __builtin_amdgcn_s_barrier()
#define PG8_SCHED __builtin_amdgcn_sched_barrier(0)
    Unit cur, nxt; int ui = 0;
    if (!S.next(0, cur)) return;
    f32x4 acc[2][2][4][2];
#pragma unroll
    for (int a = 0; a < 2; ++a)
#pragma unroll
        for (int b = 0; b < 2; ++b)
#pragma unroll
            for (int m = 0; m < 4; ++m)
#pragma unroll
                for (int n = 0; n < 2; ++n) acc[a][b][m][n] = (f32x4){0.f, 0.f, 0.f, 0.f};
    bf16x8 At[4][2], B0[2][2], B1[2][2];
    const char* cA = (const char*)g.A + (size_t)cur.pm * 2 * hA + (size_t)cur.ka * 2; const char* cB = (const char*)g.Bt + (size_t)cur.pn * 2 * hB;
    PG8_STAGE(PG8_SB(0, 0), cB, voffB); PG8_STAGE(PG8_SB(0, 1), cB + hB, voffB); PG8_STAGE(PG8_SA(0, 0), cA, voffA); PG8_STAGE(PG8_SA(0, 1), cA + hA, voffA);
    if (wr == 1) PG8_BAR;
    PG8_WAIT_V(2); PG8_BAR;
    PG8_STAGE(PG8_SB(1, 0), cB + kstep, voffB); PG8_STAGE(PG8_SA(1, 0), cA + kstep, voffA); PG8_STAGE(PG8_SB(1, 1), cB + hB + kstep, voffB);
    PG8_WAIT_V(6); PG8_BAR;
    for (;;) {
        const bool has_next = S.next(ui + 1, nxt);
        const char* nA = has_next ? (const char*)g.A + (size_t)nxt.pm * 2 * hA + (size_t)nxt.ka * 2 : cA; const char* nB = has_next ? (const char*)g.Bt + (size_t)nxt.pn * 2 * hB : cB;
        for (int t = 0; t < nt; t += 2) {
            const bool last = (t == nt - 2);
            const char* a1 = cA + (size_t)(t + 1) * kstep;
            const char* a2 = last ? nA : cA + (size_t)(t + 2) * kstep; const char* b2 = last ? nB : cB + (size_t)(t + 2) * kstep;
            const char* a3 = a2 + kstep; const char* b3 = b2 + kstep;
            PG8_LDB(B0, 0, 0); PG8_LDB(B1, 0, 1); PG8_SCHED; PG8_LDA(At, 0, 0); PG8_STAGE(PG8_SA(1, 1), a1 + hA, voffA);
            PG8_WAIT_V(8); PG8_WAIT_L(0); PG8_BAR; PG8_MMA(0, 0, At, B0); PG8_MMA(0, 1, At, B1); PG8_BAR; PG8_SCHED;
            PG8_LDA(At, 0, 1); PG8_STAGE(PG8_SB(0, 0), b2, voffB); PG8_STAGE(PG8_SB(0, 1), b2 + hB, voffB); PG8_STAGE(PG8_SA(0, 0), a2, voffA);
            PG8_WAIT_V(8); PG8_WAIT_L(0); PG8_BAR; PG8_MMA(1, 0, At, B0); PG8_MMA(1, 1, At, B1); PG8_BAR; PG8_SCHED;
            PG8_LDB(B0, 1, 0); PG8_LDB(B1, 1, 1); PG8_SCHED; PG8_LDA(At, 1, 0); PG8_STAGE(PG8_SA(0, 1), a2 + hA, voffA);
            PG8_WAIT_V(8); PG8_WAIT_L(0); PG8_BAR; PG8_MMA(0, 0, At, B0); PG8_MMA(0, 1, At, B1); PG8_BAR; PG8_SCHED;
            PG8_LDA(At, 1, 1); PG8_STAGE(PG8_SB(1, 0), b3, voffB); PG8_STAGE(PG8_SB(1, 1), b3 + hB, voffB); PG8_STAGE(PG8_SA(1, 0), a3, voffA);
            PG8_WAIT_V(8); PG8_WAIT_L(0); PG8_BAR; PG8_MMA(1, 0, At, B0); PG8_MMA(1, 1, At, B1); PG8_BAR; PG8_SCHED;
        }
        if (wr == 0) PG8_BAR;
        E(acc, cur, wr, wc, fr, fq);
        if (!has_next) break;
#pragma unroll
        for (int a = 0; a < 2; ++a)
#pragma unroll
            for (int b = 0; b < 2; ++b)
#pragma unroll
                for (int m = 0; m < 4; ++m)
#pragma unroll
                    for (int n = 0; n < 2; ++n) acc[a][b][m][n] = (f32x4){0.f, 0.f, 0.f, 0.f};
        cur = nxt; cA = nA; cB = nB; ++ui;
        if (wr == 1) PG8_BAR;
    }
    PG8_WAIT_V(0);
    PG8_BAR;
#undef PG8_SA
#undef PG8_SB
#undef PG8_STAGE
#undef PG8_LDA
#undef PG8_LDB
#undef PG8_MMA
#undef PG8_WAIT_V
#undef PG8_WAIT_L
#undef PG8_BAR
#undef PG8_SCHED
}

struct EpiSwiGLU {
    static constexpr bool PERM = true;
    bf16_t* O; int ldc;
    __device__ __forceinline__ void operator()(const f32x4 (&acc)[2][2][4][2], const Unit& u, int wr, int wc, int fr, int fq) const {
        const int row0 = u.pm * BM + wr * 64 + fr, col0 = u.pn * HALF + wc * 32 + 8 * fq;
#pragma unroll
        for (int ai = 0; ai < 2; ++ai)
#pragma unroll
            for (int m = 0; m < 4; ++m) {
                bf16_t* rowp = O + (size_t)(row0 + ai * HALF + m * 16) * ldc + col0;
                const f32x4 g0 = acc[ai][0][m][0], g1 = acc[ai][0][m][1], u0 = acc[ai][1][m][0], u1 = acc[ai][1][m][1];
                u32x4 w;
                w.x = cvt_pk_bf16(siluf_(g0[0]) * u0[0], siluf_(g0[1]) * u0[1]); w.y = cvt_pk_bf16(siluf_(g0[2]) * u0[2], siluf_(g0[3]) * u0[3]);
                w.z = cvt_pk_bf16(siluf_(g1[0]) * u1[0], siluf_(g1[1]) * u1[1]); w.w = cvt_pk_bf16(siluf_(g1[2]) * u1[2], siluf_(g1[3]) * u1[3]);
                *(u32x4*)rowp = w;
            }
    }
};
struct EpiResid {
    static constexpr bool PERM = false;
    const float* base_lat; const float* base_ctx; float* out_lat; float* out_ctx; const float* gate; float s;
    __device__ __forceinline__ void operator()(const f32x4 (&acc)[2][2][4][2], const Unit& u, int wr, int wc, int fr, int fq) const {
        const bool lat = u.pm < 64;
        const float* base = lat ? base_lat + (size_t)u.pm * BM * DM : base_ctx + (size_t)(u.pm - 64) * BM * DM;
        float* out = lat ? out_lat + (size_t)u.pm * BM * DM : out_ctx + (size_t)(u.pm - 64) * BM * DM;
        const float* grow = gate + (size_t)(lat ? (u.pm >> 4) : 4) * NMODC;
        const int col0 = u.pn * BM + wc * 32 + 4 * fq;
#pragma unroll
        for (int bj = 0; bj < 2; ++bj)
#pragma unroll
            for (int n = 0; n < 2; ++n) {
                const int col = col0 + bj * HALF + n * 16;
                const f32x4 gv = *(const f32x4*)(grow + col) * s;
#pragma unroll
                for (int ai = 0; ai < 2; ++ai)
#pragma unroll
                    for (int m = 0; m < 4; ++m) {
                        const size_t off = (size_t)(ai * HALF + wr * 64 + m * 16 + fr) * DM + col;
                        const f32x4 bs = *(const f32x4*)(base + off);
                        *(f32x4*)(out + off) = bs + gv * acc[ai][bj][m][n];
                    }
            }
    }
};
struct EpiInProj {
    static constexpr bool PERM = true;
    bf16_t *Q, *K, *V, *LX, *LG, *GA, *GL;
    __device__ __forceinline__ void operator()(const f32x4 (&acc)[2][2][4][2], const Unit& u, int wr, int wc, int fr, int fq) const {
        const int pn = u.pn, pm = u.pm;
        bf16_t* base; int ld, ct; bool all_rows = false, kv = false;
        if (pn < 8) { base = Q; ld = DM; ct = pn; }
        else if (pn < 10) { base = K; ld = KVW; ct = pn - 8; kv = true; all_rows = true; }
        else if (pn < 12) { base = V; ld = KVW; ct = pn - 10; kv = true; all_rows = true; }
        else if (pn < 20) { base = LX; ld = DM; ct = pn - 12; all_rows = true; }
        else if (pn < 28) { base = LG; ld = DM; ct = pn - 20; }
        else if (pn < 36) { base = GA; ld = DM; ct = pn - 28; }
        else { base = GL; ld = DM; ct = pn - 36; }
        if (!all_rows && pm >= 64) return;
        int rowbase = pm * BM;
        if (kv) rowbase = pm < 64 ? (pm >> 4) * SKV + CTXL + (pm & 15) * BM : (pm - 64) * SKV;
        const int row0 = rowbase + wr * 64 + fr, col0 = ct * BM + wc * 32 + 8 * fq;
#pragma unroll
        for (int ai = 0; ai < 2; ++ai)
#pragma unroll
            for (int m = 0; m < 4; ++m) {
                bf16_t* rowp = base + (size_t)(row0 + ai * HALF + m * 16) * ld + col0;
#pragma unroll
                for (int bj = 0; bj < 2; ++bj) {
                    const f32x4 v0 = acc[ai][bj][m][0], v1 = acc[ai][bj][m][1];
                    u32x4 w; w.x = cvt_pk_bf16(v0[0], v0[1]); w.y = cvt_pk_bf16(v0[2], v0[3]); w.z = cvt_pk_bf16(v1[0], v1[1]); w.w = cvt_pk_bf16(v1[2], v1[3]);
                    *(u32x4*)(rowp + bj * HALF) = w;
                }
            }
    }
};
struct EpiLru {
    static constexpr bool PERM = true;
    const bf16_t* XC; bf16_t *LAf, *Uf, *LAb, *Ub; const float *ba, *bx, *lam;
    __device__ __forceinline__ void operator()(const f32x4 (&acc)[2][2][4][2], const Unit& u, int wr, int wc, int fr, int fq) const {
        const int nb = u.pn >> 1, dir = u.pn & 1;
        const int ch0 = nb * 128 + wc * 32 + 8 * fq;
        bf16_t* LA = dir ? LAb : LAf; bf16_t* U = dir ? Ub : Uf;
        float cba[8], cbx[8], csp[8];
#pragma unroll
        for (int e = 0; e < 8; ++e) { cba[e] = ba[dir * DM + ch0 + e]; cbx[e] = bx[dir * DM + ch0 + e];
            const float l = lam[dir * DM + ch0 + e]; csp[e] = -8.0f * __logf(1.0f + __expf(-l)); }
        const int row0 = u.pm * BM + wr * 64 + fr;
#pragma unroll
        for (int ai = 0; ai < 2; ++ai)
#pragma unroll
            for (int m = 0; m < 4; ++m) {
                const size_t off = (size_t)(row0 + ai * HALF + m * 16) * DM + ch0;
                float xv[8]; unpack8(*(const u32x4*)(XC + off), xv);
                float la[8], uu[8];
#pragma unroll
                for (int e = 0; e < 8; ++e) {
                    const float za = acc[ai][0][m][e >> 2][e & 3] + cba[e], zx = acc[ai][1][m][e >> 2][e & 3] + cbx[e];
                    const float r = sigmoidf_(za), ig = sigmoidf_(zx);
                    const float l = csp[e] * r;
                    const float y = 2.0f * l;
                    const float em = (y > -0.02f) ? -y * (1.0f + 0.5f * y * (1.0f + 0.33333333f * y)) : 1.0f - expf_(y);
                    la[e] = l; uu[e] = __builtin_sqrtf(em) * ig * xv[e];
                }
                *(u32x4*)(LA + off) = pack8(la); *(u32x4*)(U + off) = pack8(uu);
            }
    }
};
}

namespace att {
#ifndef ATT_SDEPTH
#define ATT_SDEPTH 2
#endif
constexpr int D = 128, NW = 8, QBLK = 32, KVBLK = 64;
constexpr float SCALE = 0.088388347648318440f;
constexpr float THR = 8.f;
constexpr int LDQ = DM, LDK = KVW, LDO = DM;
constexpr size_t SHM_V = KVBLK * D * 2, SHM_K = KVBLK * D * 2, SHM_ATTN = 2 * SHM_V + 2 * SHM_K + NW * 64 * 4;
#define KSWZ(row, colB) ((row) * 256 + ((colB) ^ (((row) & 7) << 4)))
#define SBAR() __builtin_amdgcn_sched_barrier(0)
__device__ __forceinline__ int crow(int r, int hi) { return (r & 3) + 8 * (r >> 2) + 4 * hi; }
__device__ __forceinline__ void partialSM(f32x16& p0, f32x16& p1, float& m_reg, float& mn, float& alpha) {
  constexpr float C = SCALE * 1.4426950408889634f;
  float pmax = p0[0]; for (int r = 1; r < 16; ++r) pmax = fmaxf(pmax, p0[r]); for (int r = 0; r < 16; ++r) pmax = fmaxf(pmax, p1[r]);
  { auto rr = __builtin_amdgcn_permlane32_swap(__float_as_uint(pmax), __float_as_uint(pmax), false, false);
    pmax = fmaxf(__uint_as_float(rr[0]), __uint_as_float(rr[1])); }
  if (__builtin_expect(__all(pmax - m_reg <= THR / SCALE), 1)) { mn = m_reg; alpha = 1.f; }
  else { mn = fmaxf(m_reg, pmax); alpha = __builtin_amdgcn_exp2f((m_reg - mn) * C); m_reg = mn; }
  float mnC = -mn * C;
  for (int r = 0; r < 16; ++r) p0[r] = fmaf(p0[r], C, mnC); for (int r = 0; r < 16; ++r) p1[r] = fmaf(p1[r], C, mnC);
  for (int r = 0; r < 16; ++r) p0[r] = __builtin_amdgcn_exp2f(p0[r]);
}
__device__ __forceinline__ void finishSM(f32x16& p0, f32x16& p1, float alpha, float& l_reg, bf16x8& pa0, bf16x8& pa1, bf16x8& pa2, bf16x8& pa3) {
  for (int r = 0; r < 16; ++r) p1[r] = __builtin_amdgcn_exp2f(p1[r]);
  float ps = 0; for (int r = 0; r < 16; ++r) ps += p0[r]; for (int r = 0; r < 16; ++r) ps += p1[r];
  { auto rr = __builtin_amdgcn_permlane32_swap(__float_as_uint(ps), __float_as_uint(ps), false, false);
    ps = __uint_as_float(rr[0]) + __uint_as_float(rr[1]); }
  l_reg = l_reg * alpha + ps;
#define PK4(P, BASE, OUT) do { unsigned a0 = cvt_pk_bf16(P[BASE + 0], P[BASE + 1]), a1 = cvt_pk_bf16(P[BASE + 2], P[BASE + 3]);   \
    unsigned b0 = cvt_pk_bf16(P[BASE + 4], P[BASE + 5]), b1 = cvt_pk_bf16(P[BASE + 6], P[BASE + 7]);                              \
    auto r0 = __builtin_amdgcn_permlane32_swap(a0, b0, false, false); auto r1 = __builtin_amdgcn_permlane32_swap(a1, b1, false, false); \
    u32x4 w = {r0[0], r1[0], r0[1], r1[1]}; OUT = *reinterpret_cast<bf16x8*>(&w); } while (0)
  PK4(p0, 0, pa0); PK4(p0, 8, pa1); PK4(p1, 0, pa2); PK4(p1, 8, pa3);
#undef PK4
}
__device__ __forceinline__ void qkt(f32x16& p0, f32x16& p1, const bf16_t* Ks, const bf16x8* qr, int r32, int hi) {
  p0 = f32x16{}; p1 = f32x16{};
  for (int d0 = 0; d0 < 8; ++d0) { int cb = (d0 * 16 + hi * 8) * 2;
    bf16x8 b0 = *reinterpret_cast<const bf16x8*>((const char*)Ks + KSWZ(r32, cb));
    bf16x8 b1 = *reinterpret_cast<const bf16x8*>((const char*)Ks + KSWZ(32 + r32, cb));
    p0 = __builtin_amdgcn_mfma_f32_32x32x16_bf16(b0, qr[d0], p0, 0, 0, 0);
    p1 = __builtin_amdgcn_mfma_f32_32x32x16_bf16(b1, qr[d0], p1, 0, 0, 0); }
}
__device__ __forceinline__ int v_st(int k, int c) { const int kk = (k & ~0xC) | ((k & 4) << 1) | ((k & 8) >> 1); return ((kk >> 3) * 4 + (c >> 5)) * 512 + ((kk & 7) * 32 + (c & 31)) * 2; }
__device__ __forceinline__ int v_rd_base(int lane) { return ((lane & 3) << 3) | (((lane >> 2) & 3) << 6) | (((lane >> 4) & 1) << 5) | (((lane >> 5) & 1) << 8); }
constexpr int v_rd_off(int d0, int ks, int half) { return d0 * 512 + ks * 4096 + half * 2048; }
template <int OFF> __device__ __forceinline__ s16x4 tr_read(int vb) {
  s16x4 r; asm volatile("ds_read_b64_tr_b16 %0, %1 offset:%2" : "=&v"(r) : "v"(vb), "i"(OFF) : "memory"); return r;
}
template <int D0> __device__ __forceinline__ void pv_one(f32x16& od, int vb, bf16x8 pa0, bf16x8 pa1, bf16x8 pa2, bf16x8 pa3) {
  const s16x4 l0 = tr_read<v_rd_off(D0, 0, 0)>(vb), h0 = tr_read<v_rd_off(D0, 0, 1)>(vb), l1 = tr_read<v_rd_off(D0, 1, 0)>(vb), h1 = tr_read<v_rd_off(D0, 1, 1)>(vb);
  const s16x4 l2 = tr_read<v_rd_off(D0, 2, 0)>(vb), h2 = tr_read<v_rd_off(D0, 2, 1)>(vb), l3 = tr_read<v_rd_off(D0, 3, 0)>(vb), h3 = tr_read<v_rd_off(D0, 3, 1)>(vb);
  asm volatile("s_waitcnt lgkmcnt(0)" ::: "memory"); SBAR();
#define PK(L, H) (bf16x8){L[0], L[1], L[2], L[3], H[0], H[1], H[2], H[3]}
  od = __builtin_amdgcn_mfma_f32_32x32x16_bf16(pa0, PK(l0, h0), od, 0, 0, 0);
  od = __builtin_amdgcn_mfma_f32_32x32x16_bf16(pa1, PK(l1, h1), od, 0, 0, 0);
  od = __builtin_amdgcn_mfma_f32_32x32x16_bf16(pa2, PK(l2, h2), od, 0, 0, 0);
  od = __builtin_amdgcn_mfma_f32_32x32x16_bf16(pa3, PK(l3, h3), od, 0, 0, 0);
#undef PK
}
__device__ __forceinline__ void pv_d0(f32x16* o, int vb, bf16x8 pa0, bf16x8 pa1, bf16x8 pa2, bf16x8 pa3) {
  pv_one<0>(o[0], vb, pa0, pa1, pa2, pa3); pv_one<1>(o[1], vb, pa0, pa1, pa2, pa3); pv_one<2>(o[2], vb, pa0, pa1, pa2, pa3); pv_one<3>(o[3], vb, pa0, pa1, pa2, pa3);
}
__device__ __forceinline__ void attn_dense_body(const bf16_t* Qb, const bf16_t* __restrict__ Kh, const bf16_t* __restrict__ Vh,
                                                bf16_t* Ob, const bf16_t* Gb, int seq, char* lds) {
  int tid = threadIdx.x; asm volatile("" : "+v"(tid));
  const int wid = tid >> 6, lane = tid & 63, r32 = lane & 31, hi = lane >> 5;
  bf16_t* V_lds = (bf16_t*)lds; bf16_t* K_lds = (bf16_t*)(lds + 2 * SHM_V);
  float* ws = (float*)(lds + 2 * SHM_V + 2 * SHM_K) + wid * 64; float* li_l = ws; float* al_l = ws + 32;
  float m_reg = -1e30f, l_reg = 0; f32x16 o[4] = {}; bf16x8 qr[8];
  const bf16_t* Qw = Qb + (long)(wid * QBLK + r32) * LDQ + hi * 8;
#pragma unroll
  for (int d0 = 0; d0 < 8; ++d0) qr[d0] = *reinterpret_cast<const bf16x8*>(Qw + d0 * 16);
  const int sr = tid >> 4, sc = (tid & 15) * 8, vst0 = v_st(sr, sc), vst1 = v_st(32 + sr, sc);
  const int vb0 = (int)(uintptr_t)V_lds + v_rd_base(lane);
  constexpr int SDEPTH = ATT_SDEPTH;
  struct { bf16x8 vs0, vs1, ks0, ks1; } sr_[SDEPTH];
#define LD8(p) (*reinterpret_cast<const bf16x8*>(p))
#define SLOAD(i, k0) do { sr_[i].vs0 = LD8(&Vh[(long)((k0) + sr) * LDK + sc]); sr_[i].vs1 = LD8(&Vh[(long)((k0) + 32 + sr) * LDK + sc]); \
    sr_[i].ks0 = LD8(&Kh[(long)((k0) + sr) * LDK + sc]); sr_[i].ks1 = LD8(&Kh[(long)((k0) + 32 + sr) * LDK + sc]); } while (0)
#define SWRITE(b, i) do { *(bf16x8*)((char*)V_lds + (b) * SHM_V + vst0) = sr_[i].vs0;          \
    *(bf16x8*)((char*)V_lds + (b) * SHM_V + vst1) = sr_[i].vs1; int kc = sc * 2;               \
    *(bf16x8*)((char*)K_lds + (b) * SHM_K + KSWZ(sr, kc)) = sr_[i].ks0;                       \
    *(bf16x8*)((char*)K_lds + (b) * SHM_K + KSWZ(32 + sr, kc)) = sr_[i].ks1; } while (0)
#define SWAIT() do { if constexpr (SDEPTH == 2) asm volatile("s_waitcnt vmcnt(4)" ::: "memory"); else asm volatile("s_waitcnt vmcnt(0)" ::: "memory"); } while (0)
#define RESC(a) do { if (__any((a) < 1.f)) { if (hi == 0) al_l[r32] = (a); asm volatile("s_waitcnt lgkmcnt(0)" ::: "memory"); \
    for (int d = 0; d < 4; ++d) for (int r = 0; r < 16; ++r) o[d][r] *= al_l[crow(r, hi)]; } } while (0)
  f32x16 pA0, pA1, pB0, pB1; float mnA, mnB, alA, alB; bf16x8 pa0, pa1, pa2, pa3; const int NT = seq / KVBLK;
  constexpr int SE = 0, SO = SDEPTH - 1;
  SLOAD(SE, 0); asm volatile("s_waitcnt vmcnt(0)" ::: "memory"); SWRITE(0, SE); __syncthreads();
  qkt(pA0, pA1, K_lds, qr, r32, hi); partialSM(pA0, pA1, m_reg, mnA, alA);
  SLOAD(SO, KVBLK); if constexpr (SDEPTH == 2) { if (2 < NT) SLOAD(SE, 2 * KVBLK); }
  SWAIT(); SWRITE(1, SO); __syncthreads();
  for (int j = 1; j + 1 < NT; j += 2) {
    SBAR(); qkt(pB0, pB1, (bf16_t*)((char*)K_lds + SHM_K), qr, r32, hi);
    finishSM(pA0, pA1, alA, l_reg, pa0, pa1, pa2, pa3); SBAR();
    SLOAD(SO, (j + SDEPTH) * KVBLK); SBAR();
    pv_d0(o, vb0, pa0, pa1, pa2, pa3); partialSM(pB0, pB1, m_reg, mnB, alB);
    __syncthreads(); SWAIT(); SWRITE(0, SE);
    RESC(alB); __syncthreads();
    SBAR(); qkt(pA0, pA1, K_lds, qr, r32, hi);
    finishSM(pB0, pB1, alB, l_reg, pa0, pa1, pa2, pa3); SBAR();
    if (SDEPTH == 1 || j + 3 < NT) SLOAD(SE, (j + 1 + SDEPTH) * KVBLK); SBAR();
    pv_d0(o, vb0 + (int)SHM_V, pa0, pa1, pa2, pa3); partialSM(pA0, pA1, m_reg, mnA, alA);
    __syncthreads(); SWAIT(); SWRITE(1, SO);
    RESC(alA); __syncthreads();
  }
  SBAR(); qkt(pB0, pB1, (bf16_t*)((char*)K_lds + SHM_K), qr, r32, hi);
  finishSM(pA0, pA1, alA, l_reg, pa0, pa1, pa2, pa3); SBAR();
  pv_d0(o, vb0, pa0, pa1, pa2, pa3); partialSM(pB0, pB1, m_reg, mnB, alB);
  __syncthreads(); RESC(alB);
  finishSM(pB0, pB1, alB, l_reg, pa0, pa1, pa2, pa3); SBAR();
  pv_d0(o, vb0 + (int)SHM_V, pa0, pa1, pa2, pa3);
  if (hi == 0) li_l[r32] = l_reg; asm volatile("s_waitcnt lgkmcnt(0)" ::: "memory");
  float rli[16];
#pragma unroll
  for (int r = 0; r < 16; ++r) rli[r] = __builtin_amdgcn_rcpf(li_l[crow(r, hi)]);
  bf16_t* Ow = Ob + (long)(wid * QBLK) * LDO; const bf16_t* Gw = Gb + (long)(wid * QBLK) * LDO;
  const int erow = lane >> 4, c16 = lane & 15;
  u32x4 gv[8];
#pragma unroll
  for (int i = 0; i < 8; ++i) gv[i] = *(const u32x4*)(Gw + (long)(i * 4 + erow) * LDO + c16 * 8);
  char* ost = lds + 69632 + wid * 8192;
#pragma unroll
  for (int r = 0; r < 16; ++r) { const int orow = crow(r, hi);
#pragma unroll
    for (int d0 = 0; d0 < 4; ++d0) { const int col = d0 * 32 + r32;
      *(bf16_t*)(ost + orow * 256 + ((col * 2) ^ ((orow & 7) << 4))) = f2bf(o[d0][r] * rli[r]); } }
  asm volatile("s_waitcnt lgkmcnt(0)" ::: "memory");
#pragma unroll
  for (int i = 0; i < 8; ++i) { const int row = i * 4 + erow;
    const u32x4 v = *(const u32x4*)(ost + row * 256 + ((c16 * 16) ^ ((row & 7) << 4)));
    float a[8], g[8]; unpack8(v, a); unpack8(gv[i], g);
#pragma unroll
    for (int e = 0; e < 8; ++e) a[e] *= sigmoidf_(g[e]);
    *(u32x4*)(Ow + (long)row * LDO + c16 * 8) = pack8(a); }
  asm volatile("s_waitcnt lgkmcnt(0)" ::: "memory");
#undef LD8
#undef SLOAD
#undef SWRITE
#undef SWAIT
#undef RESC
}
}


#define XB_TMO      128
#define XB_XCNT(j)  (256  + 64 * (j))
#define XB_XSUB(j)  (1280 + 64 * (j))
#define XB_XGEN(j)  (2304 + 64 * (j))
#define XB_TOP      3328
#define XB_TOPGEN   3392
#define XCD_BAR_WORDS 3456
#define XB_SPIN_CAP (1u << 18)
__device__ __forceinline__ unsigned xb_ld(unsigned* p)              { return __hip_atomic_load(p, __ATOMIC_RELAXED, __HIP_MEMORY_SCOPE_AGENT); }
__device__ __forceinline__ unsigned xb_add(unsigned* p, unsigned v) { return __hip_atomic_fetch_add(p, v, __ATOMIC_RELAXED, __HIP_MEMORY_SCOPE_AGENT); }
__device__ __forceinline__ unsigned xb_xcc_id() { return (unsigned)__builtin_amdgcn_s_getreg((3 << 11) | 20) & 0xFu; }
#define XB_SPIN(cond, bar) do { unsigned _sp = 0; while (cond) { __builtin_amdgcn_s_sleep(1); \
    if ((++_sp & 255u) == 0u) { if (xb_ld(&(bar)[XB_TMO])) break; if (_sp > XB_SPIN_CAP) { atomicAdd(&(bar)[XB_TMO], 1u); break; } } } } while (0)
struct XcdBarrier { unsigned* bar; unsigned x; volatile LAS unsigned* st; };
__device__ __forceinline__ XcdBarrier xcd_barrier_post(unsigned* bar, volatile LAS unsigned* st) {
    XcdBarrier b; b.bar = bar; b.x = xb_xcc_id(); b.st = st;
    if (threadIdx.x == 0) (void)xb_add(&bar[XB_XCNT(b.x)], 1u);
    return b;
}
__device__ __forceinline__ void xcd_barrier_complete(unsigned* bar, unsigned x, unsigned& nloc, unsigned& nx) {
    const unsigned G = gridDim.x * gridDim.y * gridDim.z;
    unsigned sum, cnt, mine, sp = 0u;
    for (;;) {
        sum = 0u; cnt = 0u; mine = 0u;
#pragma unroll
        for (unsigned j = 0; j < 16; ++j) { const unsigned c = xb_ld(&bar[XB_XCNT(j)]); sum += c; cnt += (c > 0u) ? 1u : 0u; mine = (j == x) ? c : mine; }
        if (sum == G) break;
        __builtin_amdgcn_s_sleep(1);
        if ((++sp & 255u) == 0u) { if (xb_ld(&bar[XB_TMO])) break; if (sp > XB_SPIN_CAP) { atomicAdd(&bar[XB_TMO], 1u); break; } }
    }
    nloc = mine > 0u ? mine : 1u; nx = cnt > 0u ? cnt : 1u;
}
__device__ __forceinline__ void xcd_barrier(const XcdBarrier& b) {
    asm volatile("s_waitcnt vmcnt(0)" ::: "memory");
    __syncthreads();
    if (threadIdx.x == 0) {
        unsigned* bar = b.bar;
        __builtin_amdgcn_s_waitcnt(0);
        unsigned nloc = b.st[0], nx = b.st[1];
        if (nloc == 0u) { xcd_barrier_complete(bar, b.x, nloc, nx); b.st[0] = nloc; b.st[1] = nx; }
        const unsigned old = xb_add(&bar[XB_XSUB(b.x)], 1u);
        const unsigned gen = old / nloc;
        if (old + 1u == (gen + 1u) * nloc) {
            __builtin_amdgcn_fence(__ATOMIC_RELEASE, "agent");
            asm volatile("s_waitcnt vmcnt(0)" ::: "memory");
            const unsigned og = xb_add(&bar[XB_TOP], 1u);
            const unsigned tg = og / nx;
            if (og + 1u == (tg + 1u) * nx) xb_add(&bar[XB_TOPGEN], 1u);
            else XB_SPIN(xb_ld(&bar[XB_TOPGEN]) == tg, bar);
            __builtin_amdgcn_fence(__ATOMIC_ACQUIRE, "agent");
            xb_add(&bar[XB_XGEN(b.x)], 1u);
            asm volatile("s_waitcnt vmcnt(0)" ::: "memory");
        } else {
            XB_SPIN(xb_ld(&bar[XB_XGEN(b.x)]) == gen, bar);
            __builtin_amdgcn_fence(__ATOMIC_ACQUIRE, "agent");
            asm volatile("s_waitcnt vmcnt(0)" ::: "memory");
        }
    }
    __syncthreads();
}

__device__ __forceinline__ void transpose_item(const float* W, int ldw, int k0, int n0, bf16_t* WT, int ldt, int drow0, LAS float* scr, int lane) {
#pragma unroll 8
    for (int i = 0; i < 32; ++i) { const int kk = 2 * i + (lane >> 5); scr[kk * 33 + (lane & 31)] = W[(size_t)(k0 + kk) * ldw + n0 + (lane & 31)]; }
    asm volatile("s_waitcnt lgkmcnt(0)" ::: "memory");
    const int c = lane & 7;
#pragma unroll
    for (int j = 0; j < 4; ++j) { const int n = (lane >> 3) + 8 * j; const LAS float* s = scr + (8 * c) * 33 + n;
        u32x4 o; o.x = cvt_pk_bf16(s[0 * 33], s[1 * 33]); o.y = cvt_pk_bf16(s[2 * 33], s[3 * 33]); o.z = cvt_pk_bf16(s[4 * 33], s[5 * 33]); o.w = cvt_pk_bf16(s[6 * 33], s[7 * 33]);
        *(u32x4*)(WT + (size_t)(drow0 + n) * ldt + k0 + 8 * c) = o; }
    asm volatile("s_waitcnt lgkmcnt(0)" ::: "memory");
}
__device__ __forceinline__ void convert_ffn(const float* wg, const float* wu, const float* wd, bf16_t* Wgu, bf16_t* Wd, LAS float* scr, int gw, int NGW, int lane) {
    constexpr int I_G = 32 * 176, I_D = 88 * 64;
    for (int it = gw; it < 2 * I_G + I_D; it += NGW) {
        if (it < 2 * I_G) { const int which = it >= I_G, r = which ? it - I_G : it; const int kb = r / 176, nb = r % 176, n0 = nb * 32;
            transpose_item(which ? wu : wg, DFF, kb * 64, n0, Wgu, DM, (n0 >> 7) * 256 + (n0 & 127) + which * 128, scr, lane); }
        else { const int r = it - 2 * I_G; const int kb = r / 64, nb = r % 64;
            transpose_item(wd, DM, kb * 64, nb * 32, Wd, DFF, nb * 32, scr, lane); }
    }
}

__device__ __forceinline__ void norm_mod_rows(const float* xlat, const float* xctx, int nrows, const float* g, const float* mod, int shi, bf16_t* H, int gw, int NGW, int lane) {
    for (int m = gw; m < nrows; m += NGW) {
        const bool lat = m < MLAT;
        const float* xr = lat ? xlat + (size_t)m * DM : xctx + (size_t)(m - MLAT) * DM;
        const float* mr = mod + (size_t)(lat ? (m >> 12) : 4) * NMODC + shi * DM;
        f32x4 v[8]; float s = 0.f;
#pragma unroll
        for (int j = 0; j < 8; ++j) { v[j] = ((const f32x4*)xr)[lane + 64 * j]; s += v[j].x * v[j].x + v[j].y * v[j].y + v[j].z * v[j].z + v[j].w * v[j].w; }
        const float rstd = 1.0f / sqrtf(wave_sum(s) * (1.0f / DM) + EPS);
#pragma unroll
        for (int j = 0; j < 8; ++j) {
            const int c4 = lane + 64 * j;
            const f32x4 gg = ((const f32x4*)g)[c4], sh = ((const f32x4*)mr)[c4], sc = ((const f32x4*)(mr + DM))[c4];
            const f32x4 y = v[j] * rstd * gg * (sc + 1.0f) + sh;
            u32x2 w; w.x = cvt_pk_bf16(y.x, y.y); w.y = cvt_pk_bf16(y.z, y.w);
            ((u32x2*)(H + (size_t)m * DM))[c4] = w;
        }
    }
}

#ifndef PH_MASK
#define PH_MASK 0xFFFFFFFu
#endif
#define PH(n) (((PH_MASK) >> (n)) & 1u)
#ifndef REP_MASK
#define REP_MASK 0u
#endif
#ifndef SYNC_REP
#define SYNC_REP 1
#endif
#define NREP(n) (PH(n) ? 1 + (int)(((REP_MASK) >> (n)) & 1u) : 0)
struct Args { const float* in[22]; float* out; unsigned char* ws; };


typedef __attribute__((address_space(4))) const unsigned long long* kargp_t;
__device__ __forceinline__ unsigned long long kload(int i) {
    unsigned long long p = (unsigned long long)__builtin_amdgcn_kernarg_segment_ptr();
    asm volatile("" : "+s"(p));
    const unsigned long long v = ((kargp_t)p)[i];
    const unsigned lo = __builtin_amdgcn_readfirstlane((unsigned)v), hi = __builtin_amdgcn_readfirstlane((unsigned)(v >> 32));
    return ((unsigned long long)hi << 32) | lo;
}
#define GAS __attribute__((address_space(1)))
#define INP(i) ((const float*)(GAS const float*)kload(i))
#define wsb ((GAS unsigned char*)kload(23))
#define outp ((float*)(GAS float*)kload(22))
#define xin INP(0)
#define cvec INP(1)
#define ctx INP(2)
#define c_ctx INP(3)
#define w_mod INP(4)
#define b_mod INP(5)
#define norm_g INP(6)
#define ffn_wg INP(7)
#define ffn_wu INP(8)
#define ffn_wd INP(9)
#define w_in INP(10)
#define w_out INP(11)
#define q_norm_g INP(12)
#define k_norm_g INP(13)
#define conv_w INP(14)
#define conv_b INP(15)
#define lru_wa INP(16)
#define lru_ba INP(17)
#define lru_wx INP(18)
#define lru_bx INP(19)
#define lru_lambda INP(20)
#define final_g INP(21)
#define MOD ((float*)(GAS float*)(wsb + WS_MOD))
#define MODP ((float*)(GAS float*)(wsb + WS_MODP))
#define CA ((float*)(GAS float*)(wsb + WS_CA))
#define CB ((float*)(GAS float*)(wsb + WS_CB))
#define SS ((float*)(GAS float*)(wsb + WS_SS))
#define XC1 ((float*)(GAS float*)(wsb + WS_XC1))
#define Wout_t ((bf16_t*)(GAS bf16_t*)(wsb + WS_WOUT))
#define Wlru_t ((bf16_t*)(GAS bf16_t*)(wsb + WS_WLRU))
#define Wgu_t ((bf16_t*)(GAS bf16_t*)(wsb + WS_WGU))
#define Wd_t ((bf16_t*)(GAS bf16_t*)(wsb + WS_WD))
#define Win_t ((bf16_t*)(GAS bf16_t*)(wsb + WS_WIN))
#define H ((bf16_t*)(GAS bf16_t*)(wsb + WS_H))
#define ACT ((bf16_t*)(GAS bf16_t*)(wsb + WS_ACT))
#define Qb ((bf16_t*)(GAS bf16_t*)(wsb + WS_Q))
#define GAb ((bf16_t*)(GAS bf16_t*)(wsb + WS_GA))
#define Kb ((bf16_t*)(GAS bf16_t*)(wsb + WS_K))
#define Vb ((bf16_t*)(GAS bf16_t*)(wsb + WS_V))
#define LXb ((bf16_t*)(GAS bf16_t*)(wsb + WS_LX))
#define LGb ((bf16_t*)(GAS bf16_t*)(wsb + WS_LG))
#define GLb ((bf16_t*)(GAS bf16_t*)(wsb + WS_GL))
#define LAf ((bf16_t*)(GAS bf16_t*)(wsb + WS_LAF))
#define Uf ((bf16_t*)(GAS bf16_t*)(wsb + WS_UF))
#define LAb ((bf16_t*)(GAS bf16_t*)(wsb + WS_LAB))
#define Ub ((bf16_t*)(GAS bf16_t*)(wsb + WS_UB))

#define GSYNC() do { for (int sr_ = 0; sr_ < SYNC_REP; ++sr_) xcd_barrier(xbar); } while (0)
__global__ void __launch_bounds__(NTHR, 2) mk_fwd(Args args) {
    extern __shared__ __attribute__((aligned(16))) unsigned char lds[];
    cg::grid_group grid = cg::this_grid();
    LAS unsigned char* L = (LAS unsigned char*)lds;
    const int G = gridDim.x, bx = blockIdx.x;
    volatile LAS unsigned* xst = (volatile LAS unsigned*)(L + LDS_BYTES - 64);
    if (threadIdx.x < 2) xst[threadIdx.x] = 0u;
    if (bx == 0) { unsigned* bw = (unsigned*)(GAS unsigned*)(wsb + WS_BAR); for (int i = threadIdx.x; i < XCD_BAR_WORDS; i += NTHR) bw[i] = 0u; }
    XcdBarrier xbar;
#define IDS() int tid = threadIdx.x; asm volatile("" : "+v"(tid)); const int lane = tid & 63, wave = __builtin_amdgcn_readfirstlane(tid >> 6); \
    const int gw = bx * NWAVES + wave, NGW = G * NWAVES; const int gt = bx * NTHR + tid, NGT = G * NTHR; LAS float* scr = (LAS float*)(L + wave * 16384); \
    (void)lane; (void)gw; (void)NGW; (void)gt; (void)NGT; (void)scr;

_Pragma("unroll")
    for (int rep_ = 0; rep_ < NREP(0); ++rep_)
    { if (rep_) xcd_barrier(xbar); IDS();
        for (int it = gw; it < 72 * 32; it += NGW) {
            const int jb = it % 72, kc = it / 72, j0 = jb * 256 + 4 * lane, k0 = kc * 64;
            float s[5];
#pragma unroll
            for (int r = 0; r < 5; ++r) { const float cv = r < 4 ? cvec[r * DM + k0 + lane] : c_ctx[k0 + lane]; s[r] = siluf_(cv); }
            f32x4 acc[5];
#pragma unroll
            for (int r = 0; r < 5; ++r) acc[r] = (f32x4){0.f, 0.f, 0.f, 0.f};
#pragma unroll 8
            for (int k = 0; k < 64; ++k) {
                const f32x4 w = *(const f32x4*)(w_mod + (size_t)(k0 + k) * NMODC + j0);
#pragma unroll
                for (int r = 0; r < 5; ++r) { const float sr = __uint_as_float(__builtin_amdgcn_readlane(__float_as_uint(s[r]), k)); acc[r] += w * sr; }
            }
#pragma unroll
            for (int r = 0; r < 5; ++r) *(f32x4*)(MODP + (size_t)(kc * 5 + r) * NMODC + j0) = acc[r];
        }
        convert_ffn(ffn_wg, ffn_wu, ffn_wd, Wgu_t, Wd_t, scr, gw, NGW, lane);
        constexpr int I_IN = 32 * 352, I_OUT = 32 * 64, I_LRU = 64 * 8;
        for (int it = gw; it < I_IN + I_OUT + I_LRU; it += NGW) {
            if (it < I_IN) { const int kb = it / 352, nb = it % 352; transpose_item(w_in, INW, kb * 64, nb * 32, Win_t, DM, nb * 32, scr, lane); }
            else if (it < I_IN + I_OUT) { const int r = it - I_IN, kb = r / 64, nb = r % 64; transpose_item(w_out, DM, kb * 64, nb * 32, Wout_t, DM, nb * 32, scr, lane); }
            else { const int r = it - I_IN - I_OUT, mat = r >> 3, sub = r & 7, kb = sub >> 2, nb4 = sub & 3;
                const int which = mat >> 5, dir = (mat >> 4) & 1, nb = mat & 15;
                const float* src = (which ? lru_wx : lru_wa) + (size_t)(dir * 16 + nb) * 128 * 128;
                transpose_item(src, 128, kb * 64, nb4 * 32, Wlru_t, 128, (nb * 2 + dir) * 256 + which * 128 + nb4 * 32, scr, lane); }
        }
    }
    grid.sync();
    xbar = xcd_barrier_post((unsigned*)(GAS unsigned*)(wsb + WS_BAR), xst);
_Pragma("unroll")
    for (int rep_ = 0; rep_ < NREP(17); ++rep_)
    { if (rep_) xcd_barrier(xbar); IDS();
    for (int idx = gt; idx < 5 * (NMODC / 4); idx += NGT) {
        const int r = idx / (NMODC / 4), j4 = idx % (NMODC / 4);
        f32x4 sacc = ((const f32x4*)b_mod)[j4];
        for (int kc = 0; kc < 32; ++kc) sacc += ((const f32x4*)(MODP + (size_t)(kc * 5 + r) * NMODC))[j4];
        ((f32x4*)(MOD + (size_t)r * NMODC))[j4] = sacc;
    }
    }
    GSYNC();
_Pragma("unroll")
    for (int rep_ = 0; rep_ < NREP(1); ++rep_)
    { if (rep_) xcd_barrier(xbar); IDS();
    norm_mod_rows(xin, ctx, MALL, norm_g, MOD, 0, H, gw, NGW, lane);
    }
    GSYNC();
_Pragma("unroll")
    for (int rep_ = 0; rep_ < NREP(2); ++rep_)
    { if (rep_) xcd_barrier(xbar); IDS();
        pg8::Gemm g{H, Wgu_t, DM, DM, DM}; pg8::StaticOrder S; S.init(MALL, NGU, G, bx);
        pg8::EpiSwiGLU E{ACT, DFF};
        pg8::gemm_phase<pg8::EpiSwiGLU, pg8::StaticOrder>(L, g, S, E);
    }
    GSYNC();
_Pragma("unroll")
    for (int rep_ = 0; rep_ < NREP(3); ++rep_)
    { if (rep_) xcd_barrier(xbar); IDS();
        pg8::Gemm g{ACT, Wd_t, DFF, DFF, DFF}; pg8::StaticOrder S; S.init(MALL, DM, G, bx);
        pg8::EpiResid E{xin, ctx, outp, XC1, MOD + 2 * DM, 0.5f};
        pg8::gemm_phase<pg8::EpiResid, pg8::StaticOrder>(L, g, S, E);
    }
    GSYNC();
_Pragma("unroll")
    for (int rep_ = 0; rep_ < NREP(4); ++rep_)
    { if (rep_) xcd_barrier(xbar); IDS();
    norm_mod_rows(outp, XC1, MALL, norm_g + DM, MOD, 3, H, gw, NGW, lane);
    }
    GSYNC();
_Pragma("unroll")
    for (int rep_ = 0; rep_ < NREP(5); ++rep_)
    { if (rep_) xcd_barrier(xbar); IDS();
        pg8::Gemm g{H, Win_t, DM, DM, DM}; pg8::StaticOrder S; S.init(MALL, INW, G, bx);
        pg8::EpiInProj E{Qb, Kb, Vb, LXb, LGb, GAb, GLb};
        pg8::gemm_phase<pg8::EpiInProj, pg8::StaticOrder>(L, g, S, E);
    }
    GSYNC();
_Pragma("unroll")
    for (int rep_ = 0; rep_ < NREP(6); ++rep_)
    { if (rep_) xcd_barrier(xbar); IDS();
        bf16_t* XC = H;
        const int l16 = lane & 15;
        float gq[8], gk[8];
#pragma unroll
        for (int e = 0; e < 8; ++e) { gq[e] = q_norm_g[l16 * 8 + e]; gk[e] = k_norm_g[l16 * 8 + e]; }
        for (int m = gw; m < MALL; m += NGW) {
            const bool lat = m < MLAT;
            const int t = lat ? (m & (SEQ - 1)) : ((m - MLAT) & (CTXL - 1));
            const int b = lat ? (m >> 12) : ((m - MLAT) >> 8);
            float cs[4], sn[4];
#pragma unroll
            for (int p = 0; p < 4; ++p) { const int i = l16 * 4 + p; const int pos = (i < 32) ? (t >> 6) : (t & 63); const int j = i & 31;
                const float freq = __builtin_amdgcn_exp2f(-(float)j * (13.287712379549449f / 32.0f)); const float ang = (float)pos * freq;
                cs[p] = lat ? __cosf(ang) : 1.0f; sn[p] = lat ? __sinf(ang) : 0.0f; }
            const int kvrow = lat ? b * SKV + CTXL + t : b * SKV + t;
            bf16_t* kp = Kb + (size_t)kvrow * KVW + lane * 8;
            bf16_t* qp = Qb + (size_t)m * DM + lane * 8;
            u32x4 raw[5];
            raw[4] = *(const u32x4*)kp;
            if (lat) {
#pragma unroll
                for (int a = 0; a < 4; ++a) raw[a] = *(const u32x4*)(qp + a * 512);
            }
#pragma unroll
            for (int a = 0; a < 5; ++a) {
                if (a < 4 && !lat) continue;
                float xv[8]; unpack8(raw[a], xv);
                float ss = 0.f;
#pragma unroll
                for (int e = 0; e < 8; ++e) ss += xv[e] * xv[e];
                ss += __shfl_xor(ss, 1); ss += __shfl_xor(ss, 2); ss += __shfl_xor(ss, 4); ss += __shfl_xor(ss, 8);
                const float rs = 1.0f / sqrtf(ss * (1.0f / 128.0f) + EPS);
                float y[8];
#pragma unroll
                for (int e = 0; e < 8; ++e) y[e] = xv[e] * rs * (a < 4 ? gq[e] : gk[e]);
#pragma unroll
                for (int pp = 0; pp < 4; ++pp) { const float y0 = y[2 * pp], y1 = y[2 * pp + 1]; y[2 * pp] = y0 * cs[pp] - y1 * sn[pp]; y[2 * pp + 1] = y0 * sn[pp] + y1 * cs[pp]; }
                *(u32x4*)(a < 4 ? qp + a * 512 : kp) = pack8(y);
            }
        }
        for (int it = gw; it < (MALL / 32) * 4; it += NGW) {
            const int a = it & 3, rb = it >> 2, m0 = rb * 32, col = a * 512 + lane * 8;
            const bool lat = m0 < MLAT;
            const int t0 = lat ? (m0 & (SEQ - 1)) : ((m0 - MLAT) & (CTXL - 1));
            const int len = lat ? SEQ : CTXL;
            float w[4][8], cb[8];
#pragma unroll
            for (int d = 0; d < 4; ++d)
#pragma unroll
                for (int e = 0; e < 8; ++e) w[d][e] = conv_w[d * DM + col + e];
#pragma unroll
            for (int e = 0; e < 8; ++e) cb[e] = conv_b[col + e];
            const bf16_t* lxp = LXb + (size_t)m0 * DM + col;
            u32x4 rows[35];
#pragma unroll
            for (int r = 0; r < 35; ++r) { const int tt = t0 + r - 2; rows[r] = (tt >= 0 && tt < len) ? *(const u32x4*)(lxp + (long)(r - 2) * DM) : (u32x4){0u, 0u, 0u, 0u}; }
#pragma unroll
            for (int r = 0; r < 32; ++r) {
                float acc[8];
#pragma unroll
                for (int e = 0; e < 8; ++e) acc[e] = cb[e];
#pragma unroll
                for (int d = 0; d < 4; ++d) { float xv[8]; unpack8(rows[r + d], xv);
#pragma unroll
                    for (int e = 0; e < 8; ++e) acc[e] += xv[e] * w[d][e]; }
                *(u32x4*)(XC + (size_t)(m0 + r) * DM + col) = pack8(acc);
            }
        }
    }
    GSYNC();
_Pragma("unroll")
    for (int rep_ = 0; rep_ < NREP(7); ++rep_)
    { if (rep_) xcd_barrier(xbar); IDS();
        bf16_t* const q_ = Qb; const bf16_t* const k_ = Kb; const bf16_t* const v_ = Vb; const bf16_t* const g_ = GAb;
#pragma unroll 1
        for (int i = 0; i < 4; ++i) {
            const int xcd = bx & 7, cu = bx >> 3;
            const int pair = xcd * 2 + (i >> 1), idx = (i & 1) * 32 + cu;
            if (G != 256) break;
            const int b = pair >> 2, kvh = pair & 3, qh = kvh * 4 + (idx >> 4), qb = idx & 15;
            const size_t qoff = ((size_t)b * SEQ + qb * 256) * DM + qh * 128;
            const size_t koff = (size_t)b * SKV * KVW + kvh * 128;
            att::attn_dense_body(q_ + qoff, k_ + koff, v_ + koff, ((NREP(7) == 2 && rep_ == 0) ? (bf16_t*)LXb : q_) + qoff, g_ + qoff, SKV, (char*)lds);
            __syncthreads();
        }
    }
    GSYNC();
_Pragma("unroll")
    for (int rep_ = 0; rep_ < NREP(8); ++rep_)
    { if (rep_) xcd_barrier(xbar); IDS();
        pg8::Gemm g{H, Wlru_t, DM, 128, 128}; pg8::LruOrder S{G, bx};
        pg8::EpiLru E{H, LAf, Uf, LAb, Ub, lru_ba, lru_bx, lru_lambda};
        pg8::gemm_phase<pg8::EpiLru, pg8::LruOrder>(L, g, S, E);
    }
    GSYNC();
_Pragma("unroll")
    for (int rep_ = 0; rep_ < NREP(9); ++rep_)
    { if (rep_) xcd_barrier(xbar); IDS();
        for (int it = bx; it < 2 * 4 * 68 * 2; it += G) {
            const int half = it & 1, q = it >> 1, p = q % 68, db = q / 68, b = db & 3, dir = db >> 2;
            const int cp = half * 512 + tid;
            int rowc;
            if (dir == 0) rowc = (p < 4) ? MLAT + b * CTXL + p * 64 : b * SEQ + (p - 4) * 64;
            else rowc = (p < 4) ? MLAT + b * CTXL + (3 - p) * 64 : b * SEQ + (67 - p) * 64;
            const unsigned* LA = (const unsigned*)(dir ? LAb : LAf); const unsigned* U = (const unsigned*)(dir ? Ub : Uf);
            float s0 = 0.f, s1 = 0.f, h0 = 0.f, h1 = 0.f;
#pragma unroll 8
            for (int s = 0; s < 64; ++s) {
                const int row = rowc + (dir ? 63 - s : s);
                const unsigned la = LA[(size_t)row * (DM / 2) + cp], uu = U[(size_t)row * (DM / 2) + cp];
                const float l0 = bf_lo(la), l1 = bf_hi(la);
                s0 += l0; s1 += l1;
                h0 = expf_(l0) * h0 + bf_lo(uu); h1 = expf_(l1) * h1 + bf_hi(uu);
            }
            const size_t o = ((size_t)(dir * 4 + b) * 68 + p) * DM + 2 * cp;
            *(f32x2*)(CA + o) = (f32x2){s0, s1}; *(f32x2*)(CB + o) = (f32x2){h0, h1};
        }
    }
    GSYNC();
_Pragma("unroll")
    for (int rep_ = 0; rep_ < NREP(10); ++rep_)
    { if (rep_) xcd_barrier(xbar); IDS();
    for (int idx = gt; idx < 2 * 4 * 1024; idx += NGT) {
        const int cp = idx & 1023, db = idx >> 10;
        float h0 = 0.f, h1 = 0.f;
        const float* ca_ = CA; const float* cb_ = CB; float* ss_ = SS;
#pragma unroll 1
        for (int p0 = 0; p0 < 68; p0 += 17) {
            f32x2 a[17], bb[17];
#pragma unroll
            for (int q = 0; q < 17; ++q) { const size_t o = ((size_t)db * 68 + p0 + q) * DM + 2 * cp; a[q] = *(const f32x2*)(ca_ + o); bb[q] = *(const f32x2*)(cb_ + o); }
#pragma unroll
            for (int q = 0; q < 17; ++q) { const size_t o = ((size_t)db * 68 + p0 + q) * DM + 2 * cp;
                *(f32x2*)(ss_ + o) = (f32x2){h0, h1};
                h0 = expf_(a[q].x) * h0 + bb[q].x; h1 = expf_(a[q].y) * h1 + bb[q].y; }
        }
    }
    }
    GSYNC();
_Pragma("unroll")
    for (int rep_ = 0; rep_ < NREP(11); ++rep_)
    { if (rep_) xcd_barrier(xbar); IDS();
        LAS unsigned* hfb = (LAS unsigned*)L;
        for (int it = bx; it < 4 * 64 * 2; it += G) {
            const int half = it & 1, q = it >> 1, c = q & 63, b = q >> 6;
            const int cp = half * 512 + tid;
            const int row0 = b * SEQ + c * 64;
            {
                const f32x2 st = *(const f32x2*)(SS + ((size_t)(0 * 4 + b) * 68 + (c + 4)) * DM + 2 * cp);
                float h0 = st.x, h1 = st.y;
                const unsigned* LA = (const unsigned*)LAf + (size_t)row0 * (DM / 2) + cp; const unsigned* U = (const unsigned*)Uf + (size_t)row0 * (DM / 2) + cp;
#pragma unroll 1
                for (int s0 = 0; s0 < 64; s0 += 16) {
                    unsigned la[16], uu[16];
#pragma unroll
                    for (int j = 0; j < 16; ++j) { la[j] = LA[(size_t)(s0 + j) * (DM / 2)]; uu[j] = U[(size_t)(s0 + j) * (DM / 2)]; }
#pragma unroll
                    for (int j = 0; j < 16; ++j) {
                        h0 = expf_(bf_lo(la[j])) * h0 + bf_lo(uu[j]); h1 = expf_(bf_hi(la[j])) * h1 + bf_hi(uu[j]);
                        hfb[(s0 + j) * 512 + tid] = cvt_pk_bf16(h0, h1);
                    }
                }
            }
            {
                const f32x2 st = *(const f32x2*)(SS + ((size_t)(1 * 4 + b) * 68 + (67 - c)) * DM + 2 * cp);
                float h0 = st.x, h1 = st.y;
                const size_t ob = (size_t)row0 * (DM / 2) + cp;
                const unsigned* LA = (const unsigned*)LAb + ob; const unsigned* U = (const unsigned*)Ub + ob;
                const unsigned* LGp = (const unsigned*)LGb + ob; const unsigned* GLp = (const unsigned*)GLb + ob; unsigned* AG = (unsigned*)Qb + ob;
#pragma unroll 1
                for (int s0 = 56; s0 >= 0; s0 -= 8) {
                    unsigned la[8], uu[8], lg[8], gl[8], ag[8];
#pragma unroll
                    for (int j = 0; j < 8; ++j) { const size_t o = (size_t)(s0 + 7 - j) * (DM / 2); la[j] = LA[o]; uu[j] = U[o]; lg[j] = LGp[o]; gl[j] = GLp[o]; ag[j] = AG[o]; }
#pragma unroll
                    for (int j = 0; j < 8; ++j) {
                        const int sidx = s0 + 7 - j;
                        h0 = expf_(bf_lo(la[j])) * h0 + bf_lo(uu[j]); h1 = expf_(bf_hi(la[j])) * h1 + bf_hi(uu[j]);
                        const unsigned hf = hfb[sidx * 512 + tid];
                        const float r0 = bf_lo(ag[j]) + sigmoidf_(bf_lo(gl[j])) * (bf_lo(hf) + h0) * gelu_tanh(bf_lo(lg[j]));
                        const float r1 = bf_hi(ag[j]) + sigmoidf_(bf_hi(gl[j])) * (bf_hi(hf) + h1) * gelu_tanh(bf_hi(lg[j]));
                        AG[(size_t)sidx * (DM / 2)] = cvt_pk_bf16(r0, r1);
                    }
                }
            }
        }
        __syncthreads();
    }
    GSYNC();
_Pragma("unroll")
    for (int rep_ = 0; rep_ < NREP(12); ++rep_)
    { if (rep_) xcd_barrier(xbar); IDS();
        pg8::Gemm g{Qb, Wout_t, DM, DM, DM}; pg8::StaticOrder S; S.init(MLAT, DM, G, bx);
        float* o12 = (NREP(12) == 2 && rep_ == 0) ? (float*)(GAS float*)(wsb + WS_LG) : outp;
        pg8::EpiResid E{outp, outp, o12, o12, MOD + 5 * DM, 1.0f};
        pg8::gemm_phase<pg8::EpiResid, pg8::StaticOrder>(L, g, S, E);
    }
    GSYNC();
_Pragma("unroll")
    for (int rep_ = 0; rep_ < NREP(13); ++rep_)
    { if (rep_) xcd_barrier(xbar); IDS();
    norm_mod_rows(outp, outp, MLAT, norm_g + 2 * DM, MOD, 6, H, gw, NGW, lane);
    convert_ffn(ffn_wg + (size_t)DM * DFF, ffn_wu + (size_t)DM * DFF, ffn_wd + (size_t)DM * DFF, Wgu_t, Wd_t, scr, gw, NGW, lane);
    }
    GSYNC();
_Pragma("unroll")
    for (int rep_ = 0; rep_ < NREP(14); ++rep_)
    { if (rep_) xcd_barrier(xbar); IDS();
        pg8::Gemm g{H, Wgu_t, DM, DM, DM}; pg8::StaticOrder S; S.init(MLAT, NGU, G, bx);
        pg8::EpiSwiGLU E{ACT, DFF};
        pg8::gemm_phase<pg8::EpiSwiGLU, pg8::StaticOrder>(L, g, S, E);
    }
    GSYNC();
_Pragma("unroll")
    for (int rep_ = 0; rep_ < NREP(15); ++rep_)
    { if (rep_) xcd_barrier(xbar); IDS();
        pg8::Gemm g{ACT, Wd_t, DFF, DFF, DFF}; pg8::StaticOrder S; S.init(MLAT, DM, G, bx);
        float* o15 = (NREP(15) == 2 && rep_ == 0) ? (float*)(GAS float*)(wsb + WS_LG) : outp;
        pg8::EpiResid E{outp, outp, o15, o15, MOD + 8 * DM, 0.5f};
        pg8::gemm_phase<pg8::EpiResid, pg8::StaticOrder>(L, g, S, E);
    }
    GSYNC();
_Pragma("unroll")
    for (int rep_ = 0; rep_ < NREP(16); ++rep_)
    { if (rep_) xcd_barrier(xbar); IDS();
    for (int m = gw; m < MLAT; m += NGW) {
        f32x4* xr = (f32x4*)(outp + (size_t)m * DM);
        f32x4 v[8]; float s = 0.f;
#pragma unroll
        for (int j = 0; j < 8; ++j) { v[j] = xr[lane + 64 * j]; s += v[j].x * v[j].x + v[j].y * v[j].y + v[j].z * v[j].z + v[j].w * v[j].w; }
        const float rstd = 1.0f / sqrtf(wave_sum(s) * (1.0f / DM) + EPS);
#pragma unroll
        for (int j = 0; j < 8; ++j) xr[lane + 64 * j] = v[j] * rstd * ((const f32x4*)final_g)[lane + 64 * j];
    }
    }
}

extern "C" void kernel_launch(void* const* d_in, const int* in_sizes, int n_in, void* d_out, int out_size, void* d_ws, size_t ws_size, hipStream_t stream) {
    static int grid = 0;
    if (grid == 0) {
        int dev = 0, cus = 0, per_cu = 0;
        (void)hipGetDevice(&dev);
        (void)hipDeviceGetAttribute(&cus, hipDeviceAttributeMultiprocessorCount, dev);
        if (hipFuncSetAttribute((const void*)mk_fwd, hipFuncAttributeMaxDynamicSharedMemorySize, LDS_BYTES) != hipSuccess) fprintf(stderr, "hipFuncSetAttribute failed\n");
        (void)hipOccupancyMaxActiveBlocksPerMultiprocessor(&per_cu, (const void*)mk_fwd, NTHR, LDS_BYTES);
        grid = cus;
        if (ws_size < WS_END || n_in != 22) { fprintf(stderr, "kernel_launch: ws_size %zu < %zu or n_in %d != 22\n", ws_size, (size_t)WS_END, n_in); grid = -1; }
        fprintf(stderr, "grid %d (per_cu %d) ws_size %zu\n", grid, per_cu, ws_size);
    }
    if (grid < 0) return;
    Args a{};
    for (int i = 0; i < 22; ++i) a.in[i] = (const float*)d_in[i];
    a.out = (float*)d_out; a.ws = (unsigned char*)d_ws;
    void* params[] = {&a};
    hipError_t e = hipLaunchCooperativeKernel((const void*)mk_fwd, dim3(grid), dim3(NTHR), params, LDS_BYTES, stream);
    if (e != hipSuccess) fprintf(stderr, "cooperative launch failed: %s\n", hipGetErrorString(e));
}
```

```cpp
#include <hip/hip_runtime.h>
#include <hip/hip_cooperative_groups.h>
#include <cstdio>
#include <cstdint>
namespace cg = cooperative_groups;

#define LAS __attribute__((address_space(3)))
typedef unsigned short bf16_t;
typedef short bf16x8 __attribute__((ext_vector_type(8)));
typedef short s16x4 __attribute__((ext_vector_type(4)));
typedef float f32x4 __attribute__((ext_vector_type(4)));
typedef float f32x2 __attribute__((ext_vector_type(2)));
typedef float f32x16 __attribute__((ext_vector_type(16)));
typedef unsigned u32x4 __attribute__((ext_vector_type(4)));
typedef unsigned u32x2 __attribute__((ext_vector_type(2)));

constexpr int NWAVES = 8, NTHR = 512;
constexpr int LDS_BYTES = 147456;
constexpr int DM = 2048, MLAT = 16384, MCTX = 1024, MALL = 17408, SEQ = 4096, CTXL = 256;
constexpr int DFF = 5632, NGU = 11264, INW = 11264, NMODC = 18432;
constexpr int KVW = 512, SKV = 4352;
constexpr float EPS = 1e-6f;
constexpr size_t MiB = 1u << 20;
constexpr size_t WS_MOD = 0;
constexpr size_t WS_BAR = 512 * 1024;
constexpr size_t WS_MODP = 1 * MiB;
constexpr size_t WS_CA = 13 * MiB, WS_CB = 18 * MiB, WS_SS = 23 * MiB;
constexpr size_t WS_XC1 = 28 * MiB;
constexpr size_t WS_WOUT = 36 * MiB;
constexpr size_t WS_WLRU = 44 * MiB;
constexpr size_t WS_W1X = 46 * MiB;
constexpr size_t WS_WGU = WS_W1X, WS_WD = WS_W1X + 44 * MiB, WS_WIN = WS_W1X + 66 * MiB;
constexpr size_t WS_LAB = WS_W1X, WS_UB = WS_W1X + 68 * MiB;
constexpr size_t WS_H = 182 * MiB;
constexpr size_t WS_ARENA = 250 * MiB;
constexpr size_t WS_ACT = WS_ARENA;
constexpr size_t WS_Q = WS_ARENA, WS_GA = WS_ARENA + 64 * MiB, WS_K = WS_ARENA + 128 * MiB, WS_V = WS_ARENA + 145 * MiB,
                 WS_LX = WS_ARENA + 162 * MiB, WS_LG = WS_ARENA + 230 * MiB, WS_GL = WS_ARENA + 294 * MiB;
constexpr size_t WS_LAF = WS_GA, WS_UF = WS_LX;
constexpr size_t WS_END = WS_ARENA + 358 * MiB;

__device__ __forceinline__ unsigned cvt_pk_bf16(float lo, float hi) { unsigned r; asm volatile("v_cvt_pk_bf16_f32 %0, %1, %2" : "=v"(r) : "v"(lo), "v"(hi)); return r; }
__device__ __forceinline__ float bf_lo(unsigned w) { return __uint_as_float(w << 16); }
__device__ __forceinline__ float bf_hi(unsigned w) { return __uint_as_float(w & 0xffff0000u); }
__device__ __forceinline__ float bf2f(bf16_t h) { return __uint_as_float(((unsigned)h) << 16); }
__device__ __forceinline__ bf16_t f2bf(float f) { unsigned u = __float_as_uint(f); return (bf16_t)((u + 0x7fffu + ((u >> 16) & 1u)) >> 16); }
__device__ __forceinline__ float sigmoidf_(float v) { return __builtin_amdgcn_rcpf(1.0f + __builtin_amdgcn_exp2f(-1.4426950408889634f * v)); }
__device__ __forceinline__ float siluf_(float v) { return v * sigmoidf_(v); }
__device__ __forceinline__ float gelu_tanh(float v) { const float z = 0.7978845608028654f * (v + 0.044715f * v * v * v); return v * sigmoidf_(2.0f * z); }
__device__ __forceinline__ float expf_(float v) { return __builtin_amdgcn_exp2f(1.4426950408889634f * v); }
__device__ __forceinline__ float wave_sum(float v) {
#pragma unroll
    for (int o = 1; o < 64; o <<= 1) v += __shfl_xor(v, o);
    return v;
}
__device__ __forceinline__ void unpack8(const u32x4 w, float (&x)[8]) {
    x[0] = bf_lo(w.x); x[1] = bf_hi(w.x); x[2] = bf_lo(w.y); x[3] = bf_hi(w.y); x[4] = bf_lo(w.z); x[5] = bf_hi(w.z); x[6] = bf_lo(w.w); x[7] = bf_hi(w.w);
}
__device__ __forceinline__ u32x4 pack8(const float (&x)[8]) {
    u32x4 w; w.x = cvt_pk_bf16(x[0], x[1]); w.y = cvt_pk_bf16(x[2], x[3]); w.z = cvt_pk_bf16(x[4], x[5]); w.w = cvt_pk_bf16(x[6], x[7]); return w;
}

namespace pg8 {
constexpr int BM = 256, BK = 64, HALF = 128, HTB = HALF * BK * 2, STAGE_BYTES = 8 * HTB, NXCD = 8, WGM = 8;
__device__ __forceinline__ int lds_byte(int r, int c) { const int st = (r >> 4) * 2 + (c >> 5), rr = r & 15, cc = c & 31, ob = rr * 64 + cc * 2; return st * 1024 + (ob ^ (((ob >> 9) & 1) << 5)); }
__device__ __forceinline__ void stage_rc(int b, int& R, int& C) { const int st = b / 1024, sb = b % 1024, swz = sb ^ (((sb >> 9) & 1) << 5); R = (st >> 1) * 16 + swz / 64; C = (st & 1) * 32 + (swz % 64) / 2; }
__device__ __forceinline__ int perm32(int rho) { const int n = rho >> 4, i = rho & 15; return 8 * (i >> 2) + 4 * n + (i & 3); }

struct Unit { int pm, pn, ka, kb, nk; };
struct Gemm { const bf16_t* A; const bf16_t* Bt; int lda, ldb, K; };

struct StaticOrder {
    int nM, nN, nwg, G, c, nk;
    __device__ void init(int M, int N, int G_, int c_, int K) { nM = M / BM; nN = N / BM; nwg = nM * nN; G = G_; c = c_; nk = K / BK; }
    __device__ void map(int wgid, Unit& u) const {
        { const int q = nwg / NXCD, r = nwg % NXCD, xcd = wgid % NXCD, off = wgid / NXCD; wgid = (xcd < r ? xcd * (q + 1) : r * (q + 1) + (xcd - r) * q) + off; }
        const int nig = WGM * nN, gid = wgid / nig, fm = gid * WGM, gsz = (nM - fm) < WGM ? (nM - fm) : WGM;
        u.pm = fm + ((wgid % nig) % gsz); u.pn = (wgid % nig) / gsz; u.ka = 0; u.kb = 0; u.nk = nk;
    }
    __device__ bool next(int i, Unit& u) const {
        const long L = (long)i * G + c; if (L >= nwg) return false;
        map((int)L, u); return true;
    }
};
struct DownSplitOrder {
    StaticOrder so;
    __device__ void init(int G_, int c_) { so.init(MLAT, DM, G_, c_, DFF); }
    __device__ bool next(int i, Unit& u) const {
        const int L = i * so.G + so.c;
        if (L < 512) { so.map(L, u); return true; }
        if (L >= 640) return false;
        const int j = L - 512, slice = j & 3, tile = j >> 2;
        u.pm = 64 + (tile >> 3); u.pn = tile & 7; u.ka = slice * (DFF / 4); u.kb = u.ka; u.nk = DFF / 4 / BK; return true;
    }
};
struct LruOrder {
    int G, c;
    __device__ bool next(int i, Unit& u) const {
        const int L = i * G + c; if (L >= 68 * 32) return false;
        u.pn = L & 31; u.pm = L >> 5; u.ka = (u.pn >> 1) * 128; u.kb = 0; u.nk = 2; return true;
    }
};

template <class Epi, class Sched>
__device__ __forceinline__ void gemm_phase(LAS unsigned char* lds, const Gemm g, const Sched& S, const Epi& E) {
    int tid = threadIdx.x; asm volatile("" : "+v"(tid));
    const int wid = __builtin_amdgcn_readfirstlane(tid >> 6), lane = tid & 63, wr = wid >> 2, wc = wid & 3, fr = lane & 15, fq = lane >> 4;
    unsigned voffA[2], voffB[2];
#pragma unroll
    for (int i = 0; i < 2; ++i) { int R, C; stage_rc(tid * 16 + i * 8192, R, C); const int Rb = Epi::PERM ? ((R & ~31) + perm32(R & 31)) : R;
        voffA[i] = (unsigned)(R * g.lda + C) * 2u; voffB[i] = (unsigned)(Rb * g.ldb + C) * 2u; }
    const size_t kstep = (size_t)(BK * 2);
    const size_t hA = (size_t)HALF * g.lda * 2, hB = (size_t)HALF * g.ldb * 2;
    const unsigned ldsw = (unsigned)wid * 1024u;
    const int aoff = lds_byte(wr * 64 + fr, fq * 8), boff = lds_byte(wc * 32 + fr, fq * 8);
#define PG8_SA(b, h) (((b) * 2 + (h)) * HTB)
#define PG8_SB(b, h) ((4 + (b) * 2 + (h)) * HTB)
#define PG8_STAGE(bufoff, gbase, voff) do { _Pragma("unroll") for (int _i = 0; _i < 2; ++_i) \
        __builtin_amdgcn_global_load_lds((const unsigned*)((const char*)(gbase) + (voff)[_i]), (LAS unsigned*)(lds + (bufoff) + ldsw + _i * 8192), 16, 0, 0); } while (0)
#define PG8_LDA(dst, b, h) do { _Pragma("unroll") for (int m = 0; m < 4; ++m) _Pragma("unroll") for (int k = 0; k < 2; ++k) dst[m][k] = *(const LAS bf16x8*)(lds + PG8_SA(b, h) + aoff + m * 2048 + k * 1024); } while (0)
#define PG8_LDB(dst, b, h) do { _Pragma("unroll") for (int n = 0; n < 2; ++n) _Pragma("unroll") for (int k = 0; k < 2; ++k) dst[n][k] = *(const LAS bf16x8*)(lds + PG8_SB(b, h) + boff + n * 2048 + k * 1024); } while (0)
#define PG8_MMA(ai, bj, At, Bt) do { __builtin_amdgcn_s_setprio(1); _Pragma("unroll") for (int m = 0; m < 4; ++m) _Pragma("unroll") for (int n = 0; n < 2; ++n) _Pragma("unroll") for (int k = 0; k < 2; ++k) \
        acc[ai][bj][m][n] = __builtin_amdgcn_mfma_f32_16x16x32_bf16(Bt[n][k], At[m][k], acc[ai][bj][m][n], 0, 0, 0); __builtin_amdgcn_s_setprio(0); } while (0)
#define PG8_WAIT_V(n) asm volatile("s_waitcnt vmcnt(" #n ")" ::: "memory")
#define PG8_WAIT_L(n) asm volatile("s_waitcnt lgkmcnt(" #n ")" ::: "memory")
#define PG8_BAR __builtin_amdgcn_s_barrier()
#define PG8_SCHED __builtin_amdgcn_sched_barrier(0)
    Unit cur, nxt; int ui = 0;
    if (!S.next(0, cur)) return;
    f32x4 acc[2][2][4][2];
#pragma unroll
    for (int a = 0; a < 2; ++a)
#pragma unroll
        for (int b = 0; b < 2; ++b)
#pragma unroll
            for (int m = 0; m < 4; ++m)
#pragma unroll
                for (int n = 0; n < 2; ++n) acc[a][b][m][n] = (f32x4){0.f, 0.f, 0.f, 0.f};
    bf16x8 At[4][2], B0[2][2], B1[2][2];
    const char* cA = (const char*)g.A + (size_t)cur.pm * 2 * hA + (size_t)cur.ka * 2; const char* cB = (const char*)g.Bt + (size_t)cur.pn * 2 * hB + (size_t)cur.kb * 2;
    PG8_STAGE(PG8_SB(0, 0), cB, voffB); PG8_STAGE(PG8_SB(0, 1), cB + hB, voffB); PG8_STAGE(PG8_SA(0, 0), cA, voffA); PG8_STAGE(PG8_SA(0, 1), cA + hA, voffA);
    if (wr == 1) PG8_BAR;
    PG8_WAIT_V(2); PG8_BAR;
    PG8_STAGE(PG8_SB(1, 0), cB + kstep, voffB); PG8_STAGE(PG8_SA(1, 0), cA + kstep, voffA); PG8_STAGE(PG8_SB(1, 1), cB + hB + kstep, voffB);
    PG8_WAIT_V(6); PG8_BAR;
    for (;;) {
        const bool has_next = S.next(ui + 1, nxt);
        const char* nA = has_next ? (const char*)g.A + (size_t)nxt.pm * 2 * hA + (size_t)nxt.ka * 2 : cA; const char* nB = has_next ? (const char*)g.Bt + (size_t)nxt.pn * 2 * hB + (size_t)nxt.kb * 2 : cB;
        const int nt = cur.nk;
        for (int t = 0; t < nt; t += 2) {
            const bool last = (t == nt - 2);
            const char* a1 = cA + (size_t)(t + 1) * kstep;
            const char* a2 = last ? nA : cA + (size_t)(t + 2) * kstep; const char* b2 = last ? nB : cB + (size_t)(t + 2) * kstep;
            const char* a3 = a2 + kstep; const char* b3 = b2 + kstep;
            PG8_LDB(B0, 0, 0); PG8_LDB(B1, 0, 1); PG8_SCHED; PG8_LDA(At, 0, 0); PG8_STAGE(PG8_SA(1, 1), a1 + hA, voffA);
            PG8_WAIT_V(8); PG8_WAIT_L(0); PG8_BAR; PG8_MMA(0, 0, At, B0); PG8_MMA(0, 1, At, B1); PG8_BAR; PG8_SCHED;
            PG8_LDA(At, 0, 1); PG8_STAGE(PG8_SB(0, 0), b2, voffB); PG8_STAGE(PG8_SB(0, 1), b2 + hB, voffB); PG8_STAGE(PG8_SA(0, 0), a2, voffA);
            PG8_WAIT_V(8); PG8_WAIT_L(0); PG8_BAR; PG8_MMA(1, 0, At, B0); PG8_MMA(1, 1, At, B1); PG8_BAR; PG8_SCHED;
            PG8_LDB(B0, 1, 0); PG8_LDB(B1, 1, 1); PG8_SCHED; PG8_LDA(At, 1, 0); PG8_STAGE(PG8_SA(0, 1), a2 + hA, voffA);
            PG8_WAIT_V(8); PG8_WAIT_L(0); PG8_BAR; PG8_MMA(0, 0, At, B0); PG8_MMA(0, 1, At, B1); PG8_BAR; PG8_SCHED;
            PG8_LDA(At, 1, 1); PG8_STAGE(PG8_SB(1, 0), b3, voffB); PG8_STAGE(PG8_SB(1, 1), b3 + hB, voffB); PG8_STAGE(PG8_SA(1, 0), a3, voffA);
            PG8_WAIT_V(8); PG8_WAIT_L(0); PG8_BAR; PG8_MMA(1, 0, At, B0); PG8_MMA(1, 1, At, B1); PG8_BAR; PG8_SCHED;
        }
        if (wr == 0) PG8_BAR;
        E(acc, cur, wr, wc, fr, fq);
        if (!has_next) break;
#pragma unroll
        for (int a = 0; a < 2; ++a)
#pragma unroll
            for (int b = 0; b < 2; ++b)
#pragma unroll
                for (int m = 0; m < 4; ++m)
#pragma unroll
                    for (int n = 0; n < 2; ++n) acc[a][b][m][n] = (f32x4){0.f, 0.f, 0.f, 0.f};
        cur = nxt; cA = nA; cB = nB; ++ui;
        if (wr == 1) PG8_BAR;
    }
    PG8_WAIT_V(0);
    PG8_BAR;
#undef PG8_SA
#undef PG8_SB
#undef PG8_STAGE
#undef PG8_LDA
#undef PG8_LDB
#undef PG8_MMA
#undef PG8_WAIT_V
#undef PG8_WAIT_L
#undef PG8_BAR
#undef PG8_SCHED
}

struct EpiSwiGLU {
    static constexpr bool PERM = true;
    bf16_t* O; int ldc;
    __device__ __forceinline__ void operator()(const f32x4 (&acc)[2][2][4][2], const Unit& u, int wr, int wc, int fr, int fq) const {
        const int row0 = u.pm * BM + wr * 64 + fr, col0 = u.pn * HALF + wc * 32 + 8 * fq;
#pragma unroll
        for (int ai = 0; ai < 2; ++ai)
#pragma unroll
            for (int m = 0; m < 4; ++m) {
                bf16_t* rowp = O + (size_t)(row0 + ai * HALF + m * 16) * ldc + col0;
                const f32x4 g0 = acc[ai][0][m][0], g1 = acc[ai][0][m][1], u0 = acc[ai][1][m][0], u1 = acc[ai][1][m][1];
                u32x4 w;
                w.x = cvt_pk_bf16(siluf_(g0[0]) * u0[0], siluf_(g0[1]) * u0[1]); w.y = cvt_pk_bf16(siluf_(g0[2]) * u0[2], siluf_(g0[3]) * u0[3]);
                w.z = cvt_pk_bf16(siluf_(g1[0]) * u1[0], siluf_(g1[1]) * u1[1]); w.w = cvt_pk_bf16(siluf_(g1[2]) * u1[2], siluf_(g1[3]) * u1[3]);
                *(u32x4*)rowp = w;
            }
    }
};
struct EpiResid {
    static constexpr bool PERM = false;
    const float* base_lat; const float* base_ctx; float* out_lat; float* out_ctx; const float* gate; float s;
    __device__ __forceinline__ void operator()(const f32x4 (&acc)[2][2][4][2], const Unit& u, int wr, int wc, int fr, int fq) const {
        const bool lat = u.pm < 64;
        const int slice = lat ? 0 : u.ka / (DFF / 4);
        const float* base = lat ? base_lat + (size_t)u.pm * BM * DM : base_ctx + (size_t)(u.pm - 64) * BM * DM;
        float* out = lat ? out_lat + (size_t)u.pm * BM * DM : out_ctx + (size_t)slice * MCTX * DM + (size_t)(u.pm - 64) * BM * DM;
        const float bscale = slice == 0 ? 1.0f : 0.0f;
        const float* grow = gate + (size_t)(lat ? (u.pm >> 4) : 4) * NMODC;
        const int col0 = u.pn * BM + wc * 32 + 4 * fq;
#pragma unroll
        for (int bj = 0; bj < 2; ++bj)
#pragma unroll
            for (int n = 0; n < 2; ++n) {
                const int col = col0 + bj * HALF + n * 16;
                const f32x4 gv = *(const f32x4*)(grow + col) * s;
                f32x4 bs[2][4];
#pragma unroll
                for (int ai = 0; ai < 2; ++ai)
#pragma unroll
                    for (int m = 0; m < 4; ++m) bs[ai][m] = *(const f32x4*)(base + (size_t)(ai * HALF + wr * 64 + m * 16 + fr) * DM + col);
#pragma unroll
                for (int ai = 0; ai < 2; ++ai)
#pragma unroll
                    for (int m = 0; m < 4; ++m) *(f32x4*)(out + (size_t)(ai * HALF + wr * 64 + m * 16 + fr) * DM + col) = bs[ai][m] * bscale + gv * acc[ai][bj][m][n];
                asm volatile("" ::: "memory");
            }
    }
};
struct EpiInProj {
    static constexpr bool PERM = true;
    bf16_t *Q, *K, *V, *LX, *LG, *GA, *GL;
    __device__ __forceinline__ void operator()(const f32x4 (&acc)[2][2][4][2], const Unit& u, int wr, int wc, int fr, int fq) const {
        const int pn = u.pn, pm = u.pm;
        bf16_t* base; int ld, ct; bool all_rows = false, kv = false;
        if (pn < 8) { base = Q; ld = DM; ct = pn; }
        else if (pn < 10) { base = K; ld = KVW; ct = pn - 8; kv = true; all_rows = true; }
        else if (pn < 12) { base = V; ld = KVW; ct = pn - 10; kv = true; all_rows = true; }
        else if (pn < 20) { base = LX; ld = DM; ct = pn - 12; all_rows = true; }
        else if (pn < 28) { base = LG; ld = DM; ct = pn - 20; }
        else if (pn < 36) { base = GA; ld = DM; ct = pn - 28; }
        else { base = GL; ld = DM; ct = pn - 36; }
        if (!all_rows && pm >= 64) return;
        int rowbase = pm * BM;
        if (kv) rowbase = pm < 64 ? (pm >> 4) * SKV + CTXL + (pm & 15) * BM : (pm - 64) * SKV;
        const int row0 = rowbase + wr * 64 + fr, col0 = ct * BM + wc * 32 + 8 * fq;
#pragma unroll
        for (int ai = 0; ai < 2; ++ai)
#pragma unroll
            for (int m = 0; m < 4; ++m) {
                bf16_t* rowp = base + (size_t)(row0 + ai * HALF + m * 16) * ld + col0;
#pragma unroll
                for (int bj = 0; bj < 2; ++bj) {
                    const f32x4 v0 = acc[ai][bj][m][0], v1 = acc[ai][bj][m][1];
                    u32x4 w; w.x = cvt_pk_bf16(v0[0], v0[1]); w.y = cvt_pk_bf16(v0[2], v0[3]); w.z = cvt_pk_bf16(v1[0], v1[1]); w.w = cvt_pk_bf16(v1[2], v1[3]);
                    *(u32x4*)(rowp + bj * HALF) = w;
                }
            }
    }
};
struct EpiLru {
    static constexpr bool PERM = true;
    const bf16_t* XC; bf16_t *LAf, *Uf, *LAb, *Ub; const float *ba, *bx, *lam;
    __device__ __forceinline__ void operator()(const f32x4 (&acc)[2][2][4][2], const Unit& u, int wr, int wc, int fr, int fq) const {
        const int nb = u.pn >> 1, dir = u.pn & 1;
        const int ch0 = nb * 128 + wc * 32 + 8 * fq;
        bf16_t* LA = dir ? LAb : LAf; bf16_t* U = dir ? Ub : Uf;
        float cba[8], cbx[8], csp[8];
#pragma unroll
        for (int e = 0; e < 8; ++e) { cba[e] = ba[dir * DM + ch0 + e]; cbx[e] = bx[dir * DM + ch0 + e];
            const float l = lam[dir * DM + ch0 + e]; csp[e] = -8.0f * __logf(1.0f + __expf(-l)); }
        const int row0 = u.pm * BM + wr * 64 + fr;
#pragma unroll
        for (int ai = 0; ai < 2; ++ai)
#pragma unroll
            for (int m = 0; m < 4; ++m) {
                const size_t off = (size_t)(row0 + ai * HALF + m * 16) * DM + ch0;
                float xv[8]; unpack8(*(const u32x4*)(XC + off), xv);
                float la[8], uu[8];
#pragma unroll
                for (int e = 0; e < 8; ++e) {
                    const float za = acc[ai][0][m][e >> 2][e & 3] + cba[e], zx = acc[ai][1][m][e >> 2][e & 3] + cbx[e];
                    const float r = sigmoidf_(za), ig = sigmoidf_(zx);
                    const float l = csp[e] * r;
                    const float y = 2.0f * l;
                    const float em = (y > -0.02f) ? -y * (1.0f + 0.5f * y * (1.0f + 0.33333333f * y)) : 1.0f - expf_(y);
                    la[e] = l; uu[e] = __builtin_sqrtf(em) * ig * xv[e];
                }
                *(u32x4*)(LA + off) = pack8(la); *(u32x4*)(U + off) = pack8(uu);
            }
    }
};
}

namespace att {
#ifndef ATT_SDEPTH
#define ATT_SDEPTH 2
#endif
constexpr int D = 128, NW = 8, QBLK = 32, KVBLK = 64;
constexpr float SCALE = 0.088388347648318440f;
constexpr float THR = 8.f;
constexpr int LDQ = DM, LDK = KVW, LDO = DM;
constexpr size_t SHM_V = KVBLK * D * 2, SHM_K = KVBLK * D * 2, SHM_ATTN = 2 * SHM_V + 2 * SHM_K + NW * 64 * 4;
#define KSWZ(row, colB) ((row) * 256 + ((colB) ^ (((row) & 7) << 4)))
#define SBAR() __builtin_amdgcn_sched_barrier(0)
__device__ __forceinline__ int crow(int r, int hi) { return (r & 3) + 8 * (r >> 2) + 4 * hi; }
__device__ __forceinline__ void partialSM(f32x16& p0, f32x16& p1, float& m_reg, float& mn, float& alpha) {
  constexpr float C = SCALE * 1.4426950408889634f;
  float pmax = p0[0]; for (int r = 1; r < 16; ++r) pmax = fmaxf(pmax, p0[r]); for (int r = 0; r < 16; ++r) pmax = fmaxf(pmax, p1[r]);
  { auto rr = __builtin_amdgcn_permlane32_swap(__float_as_uint(pmax), __float_as_uint(pmax), false, false);
    pmax = fmaxf(__uint_as_float(rr[0]), __uint_as_float(rr[1])); }
  if (__builtin_expect(__all(pmax - m_reg <= THR / SCALE), 1)) { mn = m_reg; alpha = 1.f; }
  else { mn = fmaxf(m_reg, pmax); alpha = __builtin_amdgcn_exp2f((m_reg - mn) * C); m_reg = mn; }
  float mnC = -mn * C;
  for (int r = 0; r < 16; ++r) p0[r] = fmaf(p0[r], C, mnC); for (int r = 0; r < 16; ++r) p1[r] = fmaf(p1[r], C, mnC);
  for (int r = 0; r < 16; ++r) p0[r] = __builtin_amdgcn_exp2f(p0[r]);
}
__device__ __forceinline__ void finishSM(f32x16& p0, f32x16& p1, float alpha, float& l_reg, bf16x8& pa0, bf16x8& pa1, bf16x8& pa2, bf16x8& pa3) {
  for (int r = 0; r < 16; ++r) p1[r] = __builtin_amdgcn_exp2f(p1[r]);
  float ps = 0; for (int r = 0; r < 16; ++r) ps += p0[r]; for (int r = 0; r < 16; ++r) ps += p1[r];
  { auto rr = __builtin_amdgcn_permlane32_swap(__float_as_uint(ps), __float_as_uint(ps), false, false);
    ps = __uint_as_float(rr[0]) + __uint_as_float(rr[1]); }
  l_reg = l_reg * alpha + ps;
#define PK4(P, BASE, OUT) do { unsigned a0 = cvt_pk_bf16(P[BASE + 0], P[BASE + 1]), a1 = cvt_pk_bf16(P[BASE + 2], P[BASE + 3]);   \
    unsigned b0 = cvt_pk_bf16(P[BASE + 4], P[BASE + 5]), b1 = cvt_pk_bf16(P[BASE + 6], P[BASE + 7]);                              \
    auto r0 = __builtin_amdgcn_permlane32_swap(a0, b0, false, false); auto r1 = __builtin_amdgcn_permlane32_swap(a1, b1, false, false); \
    u32x4 w = {r0[0], r1[0], r0[1], r1[1]}; OUT = *reinterpret_cast<bf16x8*>(&w); } while (0)
  PK4(p0, 0, pa0); PK4(p0, 8, pa1); PK4(p1, 0, pa2); PK4(p1, 8, pa3);
#undef PK4
}
__device__ __forceinline__ void qkt(f32x16& p0, f32x16& p1, const bf16_t* Ks, const bf16x8* qr, int r32, int hi) {
  p0 = f32x16{}; p1 = f32x16{};
  for (int d0 = 0; d0 < 8; ++d0) { int cb = (d0 * 16 + hi * 8) * 2;
    bf16x8 b0 = *reinterpret_cast<const bf16x8*>((const char*)Ks + KSWZ(r32, cb));
    bf16x8 b1 = *reinterpret_cast<const bf16x8*>((const char*)Ks + KSWZ(32 + r32, cb));
    p0 = __builtin_amdgcn_mfma_f32_32x32x16_bf16(b0, qr[d0], p0, 0, 0, 0);
    p1 = __builtin_amdgcn_mfma_f32_32x32x16_bf16(b1, qr[d0], p1, 0, 0, 0); }
}
__device__ __forceinline__ int v_st(int k, int c) { const int kk = (k & ~0xC) | ((k & 4) << 1) | ((k & 8) >> 1); return ((kk >> 3) * 4 + (c >> 5)) * 512 + ((kk & 7) * 32 + (c & 31)) * 2; }
__device__ __forceinline__ int v_rd_base(int lane) { return ((lane & 3) << 3) | (((lane >> 2) & 3) << 6) | (((lane >> 4) & 1) << 5) | (((lane >> 5) & 1) << 8); }
constexpr int v_rd_off(int d0, int ks, int half) { return d0 * 512 + ks * 4096 + half * 2048; }
template <int OFF> __device__ __forceinline__ s16x4 tr_read(int vb) {
  s16x4 r; asm volatile("ds_read_b64_tr_b16 %0, %1 offset:%2" : "=&v"(r) : "v"(vb), "i"(OFF) : "memory"); return r;
}
template <int D0> __device__ __forceinline__ void pv_one(f32x16& od, int vb, bf16x8 pa0, bf16x8 pa1, bf16x8 pa2, bf16x8 pa3) {
  const s16x4 l0 = tr_read<v_rd_off(D0, 0, 0)>(vb), h0 = tr_read<v_rd_off(D0, 0, 1)>(vb), l1 = tr_read<v_rd_off(D0, 1, 0)>(vb), h1 = tr_read<v_rd_off(D0, 1, 1)>(vb);
  const s16x4 l2 = tr_read<v_rd_off(D0, 2, 0)>(vb), h2 = tr_read<v_rd_off(D0, 2, 1)>(vb), l3 = tr_read<v_rd_off(D0, 3, 0)>(vb), h3 = tr_read<v_rd_off(D0, 3, 1)>(vb);
  asm volatile("s_waitcnt lgkmcnt(0)" ::: "memory"); SBAR();
#define PK(L, H) (bf16x8){L[0], L[1], L[2], L[3], H[0], H[1], H[2], H[3]}
  od = __builtin_amdgcn_mfma_f32_32x32x16_bf16(pa0, PK(l0, h0), od, 0, 0, 0);
  od = __builtin_amdgcn_mfma_f32_32x32x16_bf16(pa1, PK(l1, h1), od, 0, 0, 0);
  od = __builtin_amdgcn_mfma_f32_32x32x16_bf16(pa2, PK(l2, h2), od, 0, 0, 0);
  od = __builtin_amdgcn_mfma_f32_32x32x16_bf16(pa3, PK(l3, h3), od, 0, 0, 0);
#undef PK
}
__device__ __forceinline__ void pv_d0(f32x16* o, int vb, bf16x8 pa0, bf16x8 pa1, bf16x8 pa2, bf16x8 pa3) {
  pv_one<0>(o[0], vb, pa0, pa1, pa2, pa3); pv_one<1>(o[1], vb, pa0, pa1, pa2, pa3); pv_one<2>(o[2], vb, pa0, pa1, pa2, pa3); pv_one<3>(o[3], vb, pa0, pa1, pa2, pa3);
}
__device__ __forceinline__ void attn_dense_body(const bf16_t* Qb, const bf16_t* __restrict__ Kh, const bf16_t* __restrict__ Vh,
                                                bf16_t* Ob, const bf16_t* Gb, int seq, char* lds) {
  int tid = threadIdx.x; asm volatile("" : "+v"(tid));
  const int wid = tid >> 6, lane = tid & 63, r32 = lane & 31, hi = lane >> 5;
  bf16_t* V_lds = (bf16_t*)lds; bf16_t* K_lds = (bf16_t*)(lds + 2 * SHM_V);
  float* ws = (float*)(lds + 2 * SHM_V + 2 * SHM_K) + wid * 64; float* li_l = ws; float* al_l = ws + 32;
  float m_reg = -1e30f, l_reg = 0; f32x16 o[4] = {}; bf16x8 qr[8];
  const bf16_t* Qw = Qb + (long)(wid * QBLK + r32) * LDQ + hi * 8;
#pragma unroll
  for (int d0 = 0; d0 < 8; ++d0) qr[d0] = *reinterpret_cast<const bf16x8*>(Qw + d0 * 16);
  const int sr = tid >> 4, sc = (tid & 15) * 8, vst0 = v_st(sr, sc), vst1 = v_st(32 + sr, sc);
  const int vb0 = (int)(uintptr_t)V_lds + v_rd_base(lane);
  constexpr int SDEPTH = ATT_SDEPTH;
  struct { bf16x8 vs0, vs1, ks0, ks1; } sr_[SDEPTH];
#define LD8(p) (*reinterpret_cast<const bf16x8*>(p))
#define SLOAD(i, k0) do { sr_[i].vs0 = LD8(&Vh[(long)((k0) + sr) * LDK + sc]); sr_[i].vs1 = LD8(&Vh[(long)((k0) + 32 + sr) * LDK + sc]); \
    sr_[i].ks0 = LD8(&Kh[(long)((k0) + sr) * LDK + sc]); sr_[i].ks1 = LD8(&Kh[(long)((k0) + 32 + sr) * LDK + sc]); } while (0)
#define SWRITE(b, i) do { *(bf16x8*)((char*)V_lds + (b) * SHM_V + vst0) = sr_[i].vs0;          \
    *(bf16x8*)((char*)V_lds + (b) * SHM_V + vst1) = sr_[i].vs1; int kc = sc * 2;               \
    *(bf16x8*)((char*)K_lds + (b) * SHM_K + KSWZ(sr, kc)) = sr_[i].ks0;                       \
    *(bf16x8*)((char*)K_lds + (b) * SHM_K + KSWZ(32 + sr, kc)) = sr_[i].ks1; } while (0)
#define SWAIT() do { if constexpr (SDEPTH == 2) asm volatile("s_waitcnt vmcnt(4)" ::: "memory"); else asm volatile("s_waitcnt vmcnt(0)" ::: "memory"); } while (0)
#define RESC(a) do { if (__any((a) < 1.f)) { if (hi == 0) al_l[r32] = (a); asm volatile("s_waitcnt lgkmcnt(0)" ::: "memory"); \
    for (int d = 0; d < 4; ++d) for (int r = 0; r < 16; ++r) o[d][r] *= al_l[crow(r, hi)]; } } while (0)
  f32x16 pA0, pA1, pB0, pB1; float mnA, mnB, alA, alB; bf16x8 pa0, pa1, pa2, pa3; const int NT = seq / KVBLK;
  constexpr int SE = 0, SO = SDEPTH - 1;
  SLOAD(SE, 0); asm volatile("s_waitcnt vmcnt(0)" ::: "memory"); SWRITE(0, SE); __syncthreads();
  qkt(pA0, pA1, K_lds, qr, r32, hi); partialSM(pA0, pA1, m_reg, mnA, alA);
  SLOAD(SO, KVBLK); if constexpr (SDEPTH == 2) { if (2 < NT) SLOAD(SE, 2 * KVBLK); }
  SWAIT(); SWRITE(1, SO); __syncthreads();
  for (int j = 1; j + 1 < NT; j += 2) {
    SBAR(); qkt(pB0, pB1, (bf16_t*)((char*)K_lds + SHM_K), qr, r32, hi);
    finishSM(pA0, pA1, alA, l_reg, pa0, pa1, pa2, pa3); SBAR();
    SLOAD(SO, (j + SDEPTH) * KVBLK); SBAR();
    pv_d0(o, vb0, pa0, pa1, pa2, pa3); partialSM(pB0, pB1, m_reg, mnB, alB);
    __syncthreads(); SWAIT(); SWRITE(0, SE);
    RESC(alB); __syncthreads();
    SBAR(); qkt(pA0, pA1, K_lds, qr, r32, hi);
    finishSM(pB0, pB1, alB, l_reg, pa0, pa1, pa2, pa3); SBAR();
    if (SDEPTH == 1 || j + 3 < NT) SLOAD(SE, (j + 1 + SDEPTH) * KVBLK); SBAR();
    pv_d0(o, vb0 + (int)SHM_V, pa0, pa1, pa2, pa3); partialSM(pA0, pA1, m_reg, mnA, alA);
    __syncthreads(); SWAIT(); SWRITE(1, SO);
    RESC(alA); __syncthreads();
  }
  SBAR(); qkt(pB0, pB1, (bf16_t*)((char*)K_lds + SHM_K), qr, r32, hi);
  finishSM(pA0, pA1, alA, l_reg, pa0, pa1, pa2, pa3); SBAR();
  pv_d0(o, vb0, pa0, pa1, pa2, pa3); partialSM(pB0, pB1, m_reg, mnB, alB);
  __syncthreads(); RESC(alB);
  finishSM(pB0, pB1, alB, l_reg, pa0, pa1, pa2, pa3); SBAR();
  pv_d0(o, vb0 + (int)SHM_V, pa0, pa1, pa2, pa3);
  if (hi == 0) li_l[r32] = l_reg; asm volatile("s_waitcnt lgkmcnt(0)" ::: "memory");
  float rli[16];
#pragma unroll
  for (int r = 0; r < 16; ++r) rli[r] = __builtin_amdgcn_rcpf(li_l[crow(r, hi)]);
  bf16_t* Ow = Ob + (long)(wid * QBLK) * LDO; const bf16_t* Gw = Gb + (long)(wid * QBLK) * LDO;
  const int erow = lane >> 4, c16 = lane & 15;
  u32x4 gv[8];
#pragma unroll
  for (int i = 0; i < 8; ++i) gv[i] = *(const u32x4*)(Gw + (long)(i * 4 + erow) * LDO + c16 * 8);
  char* ost = lds + 69632 + wid * 8192;
#pragma unroll
  for (int r = 0; r < 16; ++r) { const int orow = crow(r, hi);
#pragma unroll
    for (int d0 = 0; d0 < 4; ++d0) { const int col = d0 * 32 + r32;
      *(bf16_t*)(ost + orow * 256 + ((col * 2) ^ ((orow & 7) << 4))) = f2bf(o[d0][r] * rli[r]); } }
  asm volatile("s_waitcnt lgkmcnt(0)" ::: "memory");
#pragma unroll
  for (int i = 0; i < 8; ++i) { const int row = i * 4 + erow;
    const u32x4 v = *(const u32x4*)(ost + row * 256 + ((c16 * 16) ^ ((row & 7) << 4)));
    float a[8], g[8]; unpack8(v, a); unpack8(gv[i], g);
#pragma unroll
    for (int e = 0; e < 8; ++e) a[e] *= sigmoidf_(g[e]);
    *(u32x4*)(Ow + (long)row * LDO + c16 * 8) = pack8(a); }
  asm volatile("s_waitcnt lgkmcnt(0)" ::: "memory");
#undef LD8
#undef SLOAD
#undef SWRITE
#undef SWAIT
#undef RESC
}
}


#define XB_TMO      128
#define XB_XCNT(j)  (256  + 64 * (j))
#define XB_XSUB(j)  (1280 + 64 * (j))
#define XB_XGEN(j)  (2304 + 64 * (j))
#define XB_TOP      3328
#define XB_TOPGEN   3392
#define XCD_BAR_WORDS 3456
#define XB_SPIN_CAP (1u << 18)
__device__ __forceinline__ unsigned xb_ld(unsigned* p)              { return __hip_atomic_load(p, __ATOMIC_RELAXED, __HIP_MEMORY_SCOPE_AGENT); }
__device__ __forceinline__ unsigned xb_add(unsigned* p, unsigned v) { return __hip_atomic_fetch_add(p, v, __ATOMIC_RELAXED, __HIP_MEMORY_SCOPE_AGENT); }
__device__ __forceinline__ unsigned xb_xcc_id() { return (unsigned)__builtin_amdgcn_s_getreg((3 << 11) | 20) & 0xFu; }
#define XB_SPIN(cond, bar) do { unsigned _sp = 0; while (cond) { __builtin_amdgcn_s_sleep(1); \
    if ((++_sp & 255u) == 0u) { if (xb_ld(&(bar)[XB_TMO])) break; if (_sp > XB_SPIN_CAP) { atomicAdd(&(bar)[XB_TMO], 1u); break; } } } } while (0)
struct XcdBarrier { unsigned* bar; unsigned x; volatile LAS unsigned* st; };
__device__ __forceinline__ XcdBarrier xcd_barrier_post(unsigned* bar, volatile LAS unsigned* st) {
    XcdBarrier b; b.bar = bar; b.x = xb_xcc_id(); b.st = st;
    if (threadIdx.x == 0) (void)xb_add(&bar[XB_XCNT(b.x)], 1u);
    return b;
}
__device__ __forceinline__ void xcd_barrier_complete(unsigned* bar, unsigned x, unsigned& nloc, unsigned& nx) {
    const unsigned G = gridDim.x * gridDim.y * gridDim.z;
    unsigned sum, cnt, mine, sp = 0u;
    for (;;) {
        sum = 0u; cnt = 0u; mine = 0u;
#pragma unroll
        for (unsigned j = 0; j < 16; ++j) { const unsigned c = xb_ld(&bar[XB_XCNT(j)]); sum += c; cnt += (c > 0u) ? 1u : 0u; mine = (j == x) ? c : mine; }
        if (sum == G) break;
        __builtin_amdgcn_s_sleep(1);
        if ((++sp & 255u) == 0u) { if (xb_ld(&bar[XB_TMO])) break; if (sp > XB_SPIN_CAP) { atomicAdd(&bar[XB_TMO], 1u); break; } }
    }
    nloc = mine > 0u ? mine : 1u; nx = cnt > 0u ? cnt : 1u;
}
__device__ __forceinline__ void xcd_barrier(const XcdBarrier& b) {
    asm volatile("s_waitcnt vmcnt(0)" ::: "memory");
    __syncthreads();
    if (threadIdx.x == 0) {
        unsigned* bar = b.bar;
        __builtin_amdgcn_s_waitcnt(0);
        unsigned nloc = b.st[0], nx = b.st[1];
        if (nloc == 0u) { xcd_barrier_complete(bar, b.x, nloc, nx); b.st[0] = nloc; b.st[1] = nx; }
        const unsigned old = xb_add(&bar[XB_XSUB(b.x)], 1u);
        const unsigned gen = old / nloc;
        if (old + 1u == (gen + 1u) * nloc) {
            __builtin_amdgcn_fence(__ATOMIC_RELEASE, "agent");
            asm volatile("s_waitcnt vmcnt(0)" ::: "memory");
            const unsigned og = xb_add(&bar[XB_TOP], 1u);
            const unsigned tg = og / nx;
            if (og + 1u == (tg + 1u) * nx) xb_add(&bar[XB_TOPGEN], 1u);
            else XB_SPIN(xb_ld(&bar[XB_TOPGEN]) == tg, bar);
            __builtin_amdgcn_fence(__ATOMIC_ACQUIRE, "agent");
            xb_add(&bar[XB_XGEN(b.x)], 1u);
            asm volatile("s_waitcnt vmcnt(0)" ::: "memory");
        } else {
            XB_SPIN(xb_ld(&bar[XB_XGEN(b.x)]) == gen, bar);
            __builtin_amdgcn_fence(__ATOMIC_ACQUIRE, "agent");
            asm volatile("s_waitcnt vmcnt(0)" ::: "memory");
        }
    }
    __syncthreads();
}

__device__ __forceinline__ void transpose_item(const float* W, int ldw, int k0, int n0, bf16_t* WT, int ldt, int drow0, LAS float* scr, int lane) {
    float tv[32];
#pragma unroll
    for (int i = 0; i < 32; ++i) tv[i] = W[(size_t)(k0 + 2 * i + (lane >> 5)) * ldw + n0 + (lane & 31)];
#pragma unroll
    for (int i = 0; i < 32; ++i) scr[(2 * i + (lane >> 5)) * 33 + (lane & 31)] = tv[i];
    asm volatile("s_waitcnt lgkmcnt(0)" ::: "memory");
    const int c = lane & 7;
#pragma unroll
    for (int j = 0; j < 4; ++j) { const int n = (lane >> 3) + 8 * j; const LAS float* s = scr + (8 * c) * 33 + n;
        u32x4 o; o.x = cvt_pk_bf16(s[0 * 33], s[1 * 33]); o.y = cvt_pk_bf16(s[2 * 33], s[3 * 33]); o.z = cvt_pk_bf16(s[4 * 33], s[5 * 33]); o.w = cvt_pk_bf16(s[6 * 33], s[7 * 33]);
        *(u32x4*)(WT + (size_t)(drow0 + n) * ldt + k0 + 8 * c) = o; }
    asm volatile("s_waitcnt lgkmcnt(0)" ::: "memory");
}
__device__ __forceinline__ void convert_ffn(const float* wg, const float* wu, const float* wd, bf16_t* Wgu, bf16_t* Wd, LAS float* scr, int gw, int NGW, int lane) {
    constexpr int I_G = 32 * 176, I_D = 88 * 64;
    for (int it = gw; it < 2 * I_G + I_D; it += NGW) {
        if (it < 2 * I_G) { const int which = it >= I_G, r = which ? it - I_G : it; const int kb = r / 176, nb = r % 176, n0 = nb * 32;
            transpose_item(which ? wu : wg, DFF, kb * 64, n0, Wgu, DM, (n0 >> 7) * 256 + (n0 & 127) + which * 128, scr, lane); }
        else { const int r = it - 2 * I_G; const int kb = r / 64, nb = r % 64;
            transpose_item(wd, DM, kb * 64, nb * 32, Wd, DFF, nb * 32, scr, lane); }
    }
}

template <int CTXPARTS>
__device__ __forceinline__ void norm_mod_rows(const float* xlat, const float* xctx, int nrows, const float* g, const float* mod, int shi, bf16_t* H, int gw, int NGW, int lane) {
    for (int m = gw; m < nrows; m += NGW) {
        const bool lat = m < MLAT;
        const float* xr = lat ? xlat + (size_t)m * DM : xctx + (size_t)(m - MLAT) * DM;
        const float* mr = mod + (size_t)(lat ? (m >> 12) : 4) * NMODC + shi * DM;
        f32x4 v[8]; float s = 0.f;
#pragma unroll
        for (int j = 0; j < 8; ++j) { v[j] = ((const f32x4*)xr)[lane + 64 * j];
            if (CTXPARTS > 1 && !lat) {
#pragma unroll
                for (int pp = 1; pp < CTXPARTS; ++pp) v[j] += ((const f32x4*)(xr + (size_t)pp * MCTX * DM))[lane + 64 * j];
            }
            s += v[j].x * v[j].x + v[j].y * v[j].y + v[j].z * v[j].z + v[j].w * v[j].w; }
        const float rstd = 1.0f / sqrtf(wave_sum(s) * (1.0f / DM) + EPS);
#pragma unroll
        for (int j = 0; j < 8; ++j) {
            const int c4 = lane + 64 * j;
            const f32x4 gg = ((const f32x4*)g)[c4], sh = ((const f32x4*)mr)[c4], sc = ((const f32x4*)(mr + DM))[c4];
            const f32x4 y = v[j] * rstd * gg * (sc + 1.0f) + sh;
            u32x2 w; w.x = cvt_pk_bf16(y.x, y.y); w.y = cvt_pk_bf16(y.z, y.w);
            ((u32x2*)(H + (size_t)m * DM))[c4] = w;
        }
    }
}

#ifndef PH_MASK
#define PH_MASK 0xFFFFFFFu
#endif
#define PH(n) (((PH_MASK) >> (n)) & 1u)
#ifndef REP_MASK
#define REP_MASK 0u
#endif
#ifndef SYNC_REP
#define SYNC_REP 1
#endif
#define NREP(n) (PH(n) ? 1 + (int)(((REP_MASK) >> (n)) & 1u) : 0)
struct Args { const float* in[22]; float* out; unsigned char* ws; };


typedef __attribute__((address_space(4))) const unsigned long long* kargp_t;
__device__ __forceinline__ unsigned long long kload(int i) {
    unsigned long long p = (unsigned long long)__builtin_amdgcn_kernarg_segment_ptr();
    asm volatile("" : "+s"(p));
    const unsigned long long v = ((kargp_t)p)[i];
    const unsigned lo = __builtin_amdgcn_readfirstlane((unsigned)v), hi = __builtin_amdgcn_readfirstlane((unsigned)(v >> 32));
    return ((unsigned long long)hi << 32) | lo;
}
#define GAS __attribute__((address_space(1)))
#define INP(i) ((const float*)(GAS const float*)kload(i))
#define wsb ((GAS unsigned char*)kload(23))
#define outp ((float*)(GAS float*)kload(22))
#define xin INP(0)
#define cvec INP(1)
#define ctx INP(2)
#define c_ctx INP(3)
#define w_mod INP(4)
#define b_mod INP(5)
#define norm_g INP(6)
#define ffn_wg INP(7)
#define ffn_wu INP(8)
#define ffn_wd INP(9)
#define w_in INP(10)
#define w_out INP(11)
#define q_norm_g INP(12)
#define k_norm_g INP(13)
#define conv_w INP(14)
#define conv_b INP(15)
#define lru_wa INP(16)
#define lru_ba INP(17)
#define lru_wx INP(18)
#define lru_bx INP(19)
#define lru_lambda INP(20)
#define final_g INP(21)
#define MOD ((float*)(GAS float*)(wsb + WS_MOD))
#define MODP ((float*)(GAS float*)(wsb + WS_MODP))
#define CA ((float*)(GAS float*)(wsb + WS_CA))
#define CB ((float*)(GAS float*)(wsb + WS_CB))
#define SS ((float*)(GAS float*)(wsb + WS_SS))
#define XC1P ((float*)(GAS float*)(wsb + WS_LG))
#define Wout_t ((bf16_t*)(GAS bf16_t*)(wsb + WS_WOUT))
#define Wlru_t ((bf16_t*)(GAS bf16_t*)(wsb + WS_WLRU))
#define Wgu_t ((bf16_t*)(GAS bf16_t*)(wsb + WS_WGU))
#define Wd_t ((bf16_t*)(GAS bf16_t*)(wsb + WS_WD))
#define Win_t ((bf16_t*)(GAS bf16_t*)(wsb + WS_WIN))
#define H ((bf16_t*)(GAS bf16_t*)(wsb + WS_H))
#define ACT ((bf16_t*)(GAS bf16_t*)(wsb + WS_ACT))
#define Qb ((bf16_t*)(GAS bf16_t*)(wsb + WS_Q))
#define GAb ((bf16_t*)(GAS bf16_t*)(wsb + WS_GA))
#define Kb ((bf16_t*)(GAS bf16_t*)(wsb + WS_K))
#define Vb ((bf16_t*)(GAS bf16_t*)(wsb + WS_V))
#define LXb ((bf16_t*)(GAS bf16_t*)(wsb + WS_LX))
#define LGb ((bf16_t*)(GAS bf16_t*)(wsb + WS_LG))
#define GLb ((bf16_t*)(GAS bf16_t*)(wsb + WS_GL))
#define LAf ((bf16_t*)(GAS bf16_t*)(wsb + WS_LAF))
#define Uf ((bf16_t*)(GAS bf16_t*)(wsb + WS_UF))
#define LAb ((bf16_t*)(GAS bf16_t*)(wsb + WS_LAB))
#define Ub ((bf16_t*)(GAS bf16_t*)(wsb + WS_UB))

#define GSYNC() do { for (int sr_ = 0; sr_ < SYNC_REP; ++sr_) xcd_barrier(xbar); } while (0)
__global__ void __launch_bounds__(NTHR, 2) mk_fwd(Args args) {
    extern __shared__ __attribute__((aligned(16))) unsigned char lds[];
    cg::grid_group grid = cg::this_grid();
    LAS unsigned char* L = (LAS unsigned char*)lds;
    const int G = gridDim.x, bx = blockIdx.x;
    volatile LAS unsigned* xst = (volatile LAS unsigned*)(L + LDS_BYTES - 64);
    if (threadIdx.x < 2) xst[threadIdx.x] = 0u;
    if (bx == 0) { unsigned* bw = (unsigned*)(GAS unsigned*)(wsb + WS_BAR); for (int i = threadIdx.x; i < XCD_BAR_WORDS; i += NTHR) bw[i] = 0u; }
    XcdBarrier xbar;
#define IDS() int tid = threadIdx.x; asm volatile("" : "+v"(tid)); const int lane = tid & 63, wave = __builtin_amdgcn_readfirstlane(tid >> 6); \
    const int gw = bx * NWAVES + wave, NGW = G * NWAVES; const int gt = bx * NTHR + tid, NGT = G * NTHR; LAS float* scr = (LAS float*)(L + wave * 16384); \
    (void)lane; (void)gw; (void)NGW; (void)gt; (void)NGT; (void)scr;

_Pragma("unroll")
    for (int rep_ = 0; rep_ < NREP(0); ++rep_)
    { if (rep_) xcd_barrier(xbar); IDS();
        for (int it = gw; it < 72 * 32; it += NGW) {
            const int jb = it % 72, kc = it / 72, j0 = jb * 256 + 4 * lane, k0 = kc * 64;
            float s[5];
#pragma unroll
            for (int r = 0; r < 5; ++r) { const float cv = r < 4 ? cvec[r * DM + k0 + lane] : c_ctx[k0 + lane]; s[r] = siluf_(cv); }
            f32x4 acc[5];
#pragma unroll
            for (int r = 0; r < 5; ++r) acc[r] = (f32x4){0.f, 0.f, 0.f, 0.f};
#pragma unroll 16
            for (int k = 0; k < 64; ++k) {
                const f32x4 w = *(const f32x4*)(w_mod + (size_t)(k0 + k) * NMODC + j0);
#pragma unroll
                for (int r = 0; r < 5; ++r) { const float sr = __uint_as_float(__builtin_amdgcn_readlane(__float_as_uint(s[r]), k)); acc[r] += w * sr; }
            }
#pragma unroll
            for (int r = 0; r < 5; ++r) *(f32x4*)(MODP + (size_t)(kc * 5 + r) * NMODC + j0) = acc[r];
        }
        convert_ffn(ffn_wg, ffn_wu, ffn_wd, Wgu_t, Wd_t, scr, gw, NGW, lane);
        constexpr int I_IN = 32 * 352, I_OUT = 32 * 64, I_LRU = 64 * 8;
        for (int it = gw; it < I_IN + I_OUT + I_LRU; it += NGW) {
            if (it < I_IN) { const int kb = it / 352, nb = it % 352; transpose_item(w_in, INW, kb * 64, nb * 32, Win_t, DM, nb * 32, scr, lane); }
            else if (it < I_IN + I_OUT) { const int r = it - I_IN, kb = r / 64, nb = r % 64; transpose_item(w_out, DM, kb * 64, nb * 32, Wout_t, DM, nb * 32, scr, lane); }
            else { const int r = it - I_IN - I_OUT, mat = r >> 3, sub = r & 7, kb = sub >> 2, nb4 = sub & 3;
                const int which = mat >> 5, dir = (mat >> 4) & 1, nb = mat & 15;
                const float* src = (which ? lru_wx : lru_wa) + (size_t)(dir * 16 + nb) * 128 * 128;
                transpose_item(src, 128, kb * 64, nb4 * 32, Wlru_t, 128, (nb * 2 + dir) * 256 + which * 128 + nb4 * 32, scr, lane); }
        }
    }
    grid.sync();
    xbar = xcd_barrier_post((unsigned*)(GAS unsigned*)(wsb + WS_BAR), xst);
_Pragma("unroll")
    for (int rep_ = 0; rep_ < NREP(17); ++rep_)
    { if (rep_) xcd_barrier(xbar); IDS();
    for (int idx = gt; idx < 5 * (NMODC / 4); idx += NGT) {
        const int r = idx / (NMODC / 4), j4 = idx % (NMODC / 4);
        f32x4 sacc = ((const f32x4*)b_mod)[j4];
        for (int kc = 0; kc < 32; ++kc) sacc += ((const f32x4*)(MODP + (size_t)(kc * 5 + r) * NMODC))[j4];
        ((f32x4*)(MOD + (size_t)r * NMODC))[j4] = sacc;
    }
    }
    GSYNC();
_Pragma("unroll")
    for (int rep_ = 0; rep_ < NREP(1); ++rep_)
    { if (rep_) xcd_barrier(xbar); IDS();
    norm_mod_rows<1>(xin, ctx, MALL, norm_g, MOD, 0, H, gw, NGW, lane);
    }
    GSYNC();
_Pragma("unroll")
    for (int rep_ = 0; rep_ < NREP(2); ++rep_)
    { if (rep_) xcd_barrier(xbar); IDS();
        pg8::Gemm g{H, Wgu_t, DM, DM, DM}; pg8::StaticOrder S; S.init(MALL, NGU, G, bx, DM);
        pg8::EpiSwiGLU E{ACT, DFF};
        pg8::gemm_phase<pg8::EpiSwiGLU, pg8::StaticOrder>(L, g, S, E);
    }
    GSYNC();
_Pragma("unroll")
    for (int rep_ = 0; rep_ < NREP(3); ++rep_)
    { if (rep_) xcd_barrier(xbar); IDS();
        pg8::Gemm g{ACT, Wd_t, DFF, DFF, DFF}; pg8::DownSplitOrder S; S.init(G, bx);
        pg8::EpiResid E{xin, ctx, outp, XC1P, MOD + 2 * DM, 0.5f};
        pg8::gemm_phase<pg8::EpiResid, pg8::DownSplitOrder>(L, g, S, E);
    }
    GSYNC();
_Pragma("unroll")
    for (int rep_ = 0; rep_ < NREP(4); ++rep_)
    { if (rep_) xcd_barrier(xbar); IDS();
    norm_mod_rows<4>(outp, XC1P, MALL, norm_g + DM, MOD, 3, H, gw, NGW, lane);
    }
    GSYNC();
_Pragma("unroll")
    for (int rep_ = 0; rep_ < NREP(5); ++rep_)
    { if (rep_) xcd_barrier(xbar); IDS();
        pg8::Gemm g{H, Win_t, DM, DM, DM}; pg8::StaticOrder S; S.init(MALL, INW, G, bx, DM);
        pg8::EpiInProj E{Qb, Kb, Vb, LXb, LGb, GAb, GLb};
        pg8::gemm_phase<pg8::EpiInProj, pg8::StaticOrder>(L, g, S, E);
    }
    GSYNC();
_Pragma("unroll")
    for (int rep_ = 0; rep_ < NREP(6); ++rep_)
    { if (rep_) xcd_barrier(xbar); IDS();
        bf16_t* XC = H;
        const int l16 = lane & 15;
        float gq[8], gk[8];
#pragma unroll
        for (int e = 0; e < 8; ++e) { gq[e] = q_norm_g[l16 * 8 + e]; gk[e] = k_norm_g[l16 * 8 + e]; }
        for (int m = gw; m < MALL; m += NGW) {
            const bool lat = m < MLAT;
            const int t = lat ? (m & (SEQ - 1)) : ((m - MLAT) & (CTXL - 1));
            const int b = lat ? (m >> 12) : ((m - MLAT) >> 8);
            float cs[4], sn[4];
#pragma unroll
            for (int p = 0; p < 4; ++p) { const int i = l16 * 4 + p; const int pos = (i < 32) ? (t >> 6) : (t & 63); const int j = i & 31;
                const float freq = __builtin_amdgcn_exp2f(-(float)j * (13.287712379549449f / 32.0f)); const float ang = (float)pos * freq;
                cs[p] = lat ? __cosf(ang) : 1.0f; sn[p] = lat ? __sinf(ang) : 0.0f; }
            const int kvrow = lat ? b * SKV + CTXL + t : b * SKV + t;
            bf16_t* kp = Kb + (size_t)kvrow * KVW + lane * 8;
            bf16_t* qp = Qb + (size_t)m * DM + lane * 8;
            u32x4 raw[5];
            raw[4] = *(const u32x4*)kp;
            if (lat) {
#pragma unroll
                for (int a = 0; a < 4; ++a) raw[a] = *(const u32x4*)(qp + a * 512);
            }
#pragma unroll
            for (int a = 0; a < 5; ++a) {
                if (a < 4 && !lat) continue;
                float xv[8]; unpack8(raw[a], xv);
                float ss = 0.f;
#pragma unroll
                for (int e = 0; e < 8; ++e) ss += xv[e] * xv[e];
                ss += __shfl_xor(ss, 1); ss += __shfl_xor(ss, 2); ss += __shfl_xor(ss, 4); ss += __shfl_xor(ss, 8);
                const float rs = 1.0f / sqrtf(ss * (1.0f / 128.0f) + EPS);
                float y[8];
#pragma unroll
                for (int e = 0; e < 8; ++e) y[e] = xv[e] * rs * (a < 4 ? gq[e] : gk[e]);
#pragma unroll
                for (int pp = 0; pp < 4; ++pp) { const float y0 = y[2 * pp], y1 = y[2 * pp + 1]; y[2 * pp] = y0 * cs[pp] - y1 * sn[pp]; y[2 * pp + 1] = y0 * sn[pp] + y1 * cs[pp]; }
                *(u32x4*)(a < 4 ? qp + a * 512 : kp) = pack8(y);
            }
        }
        for (int it = gw; it < (MALL / 32) * 4; it += NGW) {
            const int a = it & 3, rb = it >> 2, m0 = rb * 32, col = a * 512 + lane * 8;
            const bool lat = m0 < MLAT;
            const int t0 = lat ? (m0 & (SEQ - 1)) : ((m0 - MLAT) & (CTXL - 1));
            const int len = lat ? SEQ : CTXL;
            float w[4][8], cb[8];
#pragma unroll
            for (int d = 0; d < 4; ++d)
#pragma unroll
                for (int e = 0; e < 8; ++e) w[d][e] = conv_w[d * DM + col + e];
#pragma unroll
            for (int e = 0; e < 8; ++e) cb[e] = conv_b[col + e];
            const bf16_t* lxp = LXb + (size_t)m0 * DM + col;
            u32x4 rows[35];
#pragma unroll
            for (int r = 0; r < 35; ++r) { const int tt = t0 + r - 2; rows[r] = (tt >= 0 && tt < len) ? *(const u32x4*)(lxp + (long)(r - 2) * DM) : (u32x4){0u, 0u, 0u, 0u}; }
#pragma unroll
            for (int r = 0; r < 32; ++r) {
                float acc[8];
#pragma unroll
                for (int e = 0; e < 8; ++e) acc[e] = cb[e];
#pragma unroll
                for (int d = 0; d < 4; ++d) { float xv[8]; unpack8(rows[r + d], xv);
#pragma unroll
                    for (int e = 0; e < 8; ++e) acc[e] += xv[e] * w[d][e]; }
                *(u32x4*)(XC + (size_t)(m0 + r) * DM + col) = pack8(acc);
            }
        }
    }
    GSYNC();
_Pragma("unroll")
    for (int rep_ = 0; rep_ < NREP(7); ++rep_)
    { if (rep_) xcd_barrier(xbar); IDS();
        bf16_t* const q_ = Qb; const bf16_t* const k_ = Kb; const bf16_t* const v_ = Vb; const bf16_t* const g_ = GAb;
#pragma unroll 1
        for (int i = 0; i < 4; ++i) {
            const int xcd = bx & 7, cu = bx >> 3;
            const int pair = xcd * 2 + (i >> 1), idx = (i & 1) * 32 + cu;
            if (G != 256) break;
            const int b = pair >> 2, kvh = pair & 3, qh = kvh * 4 + (idx >> 4), qb = idx & 15;
            const size_t qoff = ((size_t)b * SEQ + qb * 256) * DM + qh * 128;
            const size_t koff = (size_t)b * SKV * KVW + kvh * 128;
            att::attn_dense_body(q_ + qoff, k_ + koff, v_ + koff, ((NREP(7) == 2 && rep_ == 0) ? (bf16_t*)LXb : q_) + qoff, g_ + qoff, SKV, (char*)lds);
            __syncthreads();
        }
    }
    GSYNC();
_Pragma("unroll")
    for (int rep_ = 0; rep_ < NREP(8); ++rep_)
    { if (rep_) xcd_barrier(xbar); IDS();
        pg8::Gemm g{H, Wlru_t, DM, 128, 128}; pg8::LruOrder S{G, bx};
        pg8::EpiLru E{H, LAf, Uf, LAb, Ub, lru_ba, lru_bx, lru_lambda};
        pg8::gemm_phase<pg8::EpiLru, pg8::LruOrder>(L, g, S, E);
    }
    GSYNC();
_Pragma("unroll")
    for (int rep_ = 0; rep_ < NREP(9); ++rep_)
    { if (rep_) xcd_barrier(xbar); IDS();
        for (int it = bx; it < 2 * 4 * 68 * 2; it += G) {
            const int half = it & 1, q = it >> 1, p = q % 68, db = q / 68, b = db & 3, dir = db >> 2;
            const int cp = half * 512 + tid;
            int rowc;
            if (dir == 0) rowc = (p < 4) ? MLAT + b * CTXL + p * 64 : b * SEQ + (p - 4) * 64;
            else rowc = (p < 4) ? MLAT + b * CTXL + (3 - p) * 64 : b * SEQ + (67 - p) * 64;
            const unsigned* LA = (const unsigned*)(dir ? LAb : LAf); const unsigned* U = (const unsigned*)(dir ? Ub : Uf);
            float s0 = 0.f, s1 = 0.f, h0 = 0.f, h1 = 0.f;
#pragma unroll 16
            for (int s = 0; s < 64; ++s) {
                const int row = rowc + (dir ? 63 - s : s);
                const unsigned la = LA[(size_t)row * (DM / 2) + cp], uu = U[(size_t)row * (DM / 2) + cp];
                const float l0 = bf_lo(la), l1 = bf_hi(la);
                s0 += l0; s1 += l1;
                h0 = expf_(l0) * h0 + bf_lo(uu); h1 = expf_(l1) * h1 + bf_hi(uu);
            }
            const size_t o = ((size_t)(dir * 4 + b) * 68 + p) * DM + 2 * cp;
            *(f32x2*)(CA + o) = (f32x2){s0, s1}; *(f32x2*)(CB + o) = (f32x2){h0, h1};
        }
    }
    GSYNC();
_Pragma("unroll")
    for (int rep_ = 0; rep_ < NREP(10); ++rep_)
    { if (rep_) xcd_barrier(xbar); IDS();
    for (int idx = gt; idx < 2 * 4 * 1024; idx += NGT) {
        const int cp = idx & 1023, db = idx >> 10;
        float h0 = 0.f, h1 = 0.f;
        const float* ca_ = CA; const float* cb_ = CB; float* ss_ = SS;
#pragma unroll 1
        for (int p0 = 0; p0 < 68; p0 += 17) {
            f32x2 a[17], bb[17];
#pragma unroll
            for (int q = 0; q < 17; ++q) { const size_t o = ((size_t)db * 68 + p0 + q) * DM + 2 * cp; a[q] = *(const f32x2*)(ca_ + o); bb[q] = *(const f32x2*)(cb_ + o); }
#pragma unroll
            for (int q = 0; q < 17; ++q) { const size_t o = ((size_t)db * 68 + p0 + q) * DM + 2 * cp;
                *(f32x2*)(ss_ + o) = (f32x2){h0, h1};
                h0 = expf_(a[q].x) * h0 + bb[q].x; h1 = expf_(a[q].y) * h1 + bb[q].y; }
        }
    }
    }
    GSYNC();
_Pragma("unroll")
    for (int rep_ = 0; rep_ < NREP(11); ++rep_)
    { if (rep_) xcd_barrier(xbar); IDS();
        LAS unsigned* hfb = (LAS unsigned*)L;
        for (int it = bx; it < 4 * 64 * 2; it += G) {
            const int half = it & 1, q = it >> 1, c = q & 63, b = q >> 6;
            const int cp = half * 512 + tid;
            const int row0 = b * SEQ + c * 64;
            {
                const f32x2 st = *(const f32x2*)(SS + ((size_t)(0 * 4 + b) * 68 + (c + 4)) * DM + 2 * cp);
                float h0 = st.x, h1 = st.y;
                const unsigned* LA = (const unsigned*)LAf + (size_t)row0 * (DM / 2) + cp; const unsigned* U = (const unsigned*)Uf + (size_t)row0 * (DM / 2) + cp;
#pragma unroll 1
                for (int s0 = 0; s0 < 64; s0 += 16) {
                    unsigned la[16], uu[16];
#pragma unroll
                    for (int j = 0; j < 16; ++j) { la[j] = LA[(size_t)(s0 + j) * (DM / 2)]; uu[j] = U[(size_t)(s0 + j) * (DM / 2)]; }
#pragma unroll
                    for (int j = 0; j < 16; ++j) {
                        h0 = expf_(bf_lo(la[j])) * h0 + bf_lo(uu[j]); h1 = expf_(bf_hi(la[j])) * h1 + bf_hi(uu[j]);
                        hfb[(s0 + j) * 512 + tid] = cvt_pk_bf16(h0, h1);
                    }
                }
            }
            {
                const f32x2 st = *(const f32x2*)(SS + ((size_t)(1 * 4 + b) * 68 + (67 - c)) * DM + 2 * cp);
                float h0 = st.x, h1 = st.y;
                const size_t ob = (size_t)row0 * (DM / 2) + cp;
                const unsigned* LA = (const unsigned*)LAb + ob; const unsigned* U = (const unsigned*)Ub + ob;
                const unsigned* LGp = (const unsigned*)LGb + ob; const unsigned* GLp = (const unsigned*)GLb + ob; unsigned* AG = (unsigned*)Qb + ob;
#pragma unroll 1
                for (int s0 = 56; s0 >= 0; s0 -= 8) {
                    unsigned la[8], uu[8], lg[8], gl[8], ag[8];
#pragma unroll
                    for (int j = 0; j < 8; ++j) { const size_t o = (size_t)(s0 + 7 - j) * (DM / 2); la[j] = LA[o]; uu[j] = U[o]; lg[j] = LGp[o]; gl[j] = GLp[o]; ag[j] = AG[o]; }
#pragma unroll
                    for (int j = 0; j < 8; ++j) {
                        const int sidx = s0 + 7 - j;
                        h0 = expf_(bf_lo(la[j])) * h0 + bf_lo(uu[j]); h1 = expf_(bf_hi(la[j])) * h1 + bf_hi(uu[j]);
                        const unsigned hf = hfb[sidx * 512 + tid];
                        const float r0 = bf_lo(ag[j]) + sigmoidf_(bf_lo(gl[j])) * (bf_lo(hf) + h0) * gelu_tanh(bf_lo(lg[j]));
                        const float r1 = bf_hi(ag[j]) + sigmoidf_(bf_hi(gl[j])) * (bf_hi(hf) + h1) * gelu_tanh(bf_hi(lg[j]));
                        AG[(size_t)sidx * (DM / 2)] = cvt_pk_bf16(r0, r1);
                    }
                }
            }
        }
        __syncthreads();
    }
    GSYNC();
_Pragma("unroll")
    for (int rep_ = 0; rep_ < NREP(12); ++rep_)
    { if (rep_) xcd_barrier(xbar); IDS();
        pg8::Gemm g{Qb, Wout_t, DM, DM, DM}; pg8::StaticOrder S; S.init(MLAT, DM, G, bx, DM);
        float* o12 = (NREP(12) == 2 && rep_ == 0) ? (float*)(GAS float*)(wsb + WS_LG) : outp;
        pg8::EpiResid E{outp, outp, o12, o12, MOD + 5 * DM, 1.0f};
        pg8::gemm_phase<pg8::EpiResid, pg8::StaticOrder>(L, g, S, E);
    }
    GSYNC();
_Pragma("unroll")
    for (int rep_ = 0; rep_ < NREP(13); ++rep_)
    { if (rep_) xcd_barrier(xbar); IDS();
    norm_mod_rows<1>(outp, outp, MLAT, norm_g + 2 * DM, MOD, 6, H, gw, NGW, lane);
    convert_ffn(ffn_wg + (size_t)DM * DFF, ffn_wu + (size_t)DM * DFF, ffn_wd + (size_t)DM * DFF, Wgu_t, Wd_t, scr, gw, NGW, lane);
    }
    GSYNC();
_Pragma("unroll")
    for (int rep_ = 0; rep_ < NREP(14); ++rep_)
    { if (rep_) xcd_barrier(xbar); IDS();
        pg8::Gemm g{H, Wgu_t, DM, DM, DM}; pg8::StaticOrder S; S.init(MLAT, NGU, G, bx, DM);
        pg8::EpiSwiGLU E{ACT, DFF};
        pg8::gemm_phase<pg8::EpiSwiGLU, pg8::StaticOrder>(L, g, S, E);
    }
    GSYNC();
_Pragma("unroll")
    for (int rep_ = 0; rep_ < NREP(15); ++rep_)
    { if (rep_) xcd_barrier(xbar); IDS();
        pg8::Gemm g{ACT, Wd_t, DFF, DFF, DFF}; pg8::StaticOrder S; S.init(MLAT, DM, G, bx, DFF);
        float* o15 = (NREP(15) == 2 && rep_ == 0) ? (float*)(GAS float*)(wsb + WS_LG) : outp;
        pg8::EpiResid E{outp, outp, o15, o15, MOD + 8 * DM, 0.5f};
        pg8::gemm_phase<pg8::EpiResid, pg8::StaticOrder>(L, g, S, E);
    }
    GSYNC();
_Pragma("unroll")
    for (int rep_ = 0; rep_ < NREP(16); ++rep_)
    { if (rep_) xcd_barrier(xbar); IDS();
    for (int m = gw; m < MLAT; m += NGW) {
        f32x4* xr = (f32x4*)(outp + (size_t)m * DM);
        f32x4 v[8]; float s = 0.f;
#pragma unroll
        for (int j = 0; j < 8; ++j) { v[j] = xr[lane + 64 * j]; s += v[j].x * v[j].x + v[j].y * v[j].y + v[j].z * v[j].z + v[j].w * v[j].w; }
        const float rstd = 1.0f / sqrtf(wave_sum(s) * (1.0f / DM) + EPS);
#pragma unroll
        for (int j = 0; j < 8; ++j) xr[lane + 64 * j] = v[j] * rstd * ((const f32x4*)final_g)[lane + 64 * j];
    }
    }
}

extern "C" void kernel_launch(void* const* d_in, const int* in_sizes, int n_in, void* d_out, int out_size, void* d_ws, size_t ws_size, hipStream_t stream) {
    static int grid = 0;
    if (grid == 0) {
        int dev = 0, cus = 0, per_cu = 0;
        (void)hipGetDevice(&dev);
        (void)hipDeviceGetAttribute(&cus, hipDeviceAttributeMultiprocessorCount, dev);
        if (hipFuncSetAttribute((const void*)mk_fwd, hipFuncAttributeMaxDynamicSharedMemorySize, LDS_BYTES) != hipSuccess) fprintf(stderr, "hipFuncSetAttribute failed\n");
        (void)hipOccupancyMaxActiveBlocksPerMultiprocessor(&per_cu, (const void*)mk_fwd, NTHR, LDS_BYTES);
        grid = cus;
        if (ws_size < WS_END || n_in != 22) { fprintf(stderr, "kernel_launch: ws_size %zu < %zu or n_in %d != 22\n", ws_size, (size_t)WS_END, n_in); grid = -1; }
        fprintf(stderr, "grid %d (per_cu %d) ws_size %zu\n", grid, per_cu, ws_size);
    }
    if (grid < 0) return;
    Args a{};
    for (int i = 0; i < 22; ++i) a.in[i] = (const float*)d_in[i];
    a.out = (float*)d_out; a.ws = (unsigned char*)d_ws;
    void* params[] = {&a};
    hipError_t e = hipLaunchCooperativeKernel((const void*)mk_fwd, dim3(grid), dim3(NTHR), params, LDS_BYTES, stream);
    if (e != hipSuccess) fprintf(stderr, "cooperative launch failed: %s\n", hipGetErrorString(e));
}
```
